# Optimizing an MI355X kernel written in HIP

```python
import jax, jax.numpy as jnp
from jax import lax
import numpy as np

D_MODEL = 2048
BATCH = 2
SEQ = 16384
DEPTH = 2

N_MIXERS = 2
POOL_WINDOWS = (2, 4, 8, 16)
N_POOL_GROUPS = len(POOL_WINDOWS)
POOL_GROUP = D_MODEL // N_POOL_GROUPS
CONV_WIDTH = 3
D_FF = ((8 * D_MODEL // 3 + 255) // 256) * 256
N_A = (DEPTH + 1) // 2
N_B = DEPTH // 2
EPS = 1e-6

kernel_name = "hybrid_pool_shortconv_convffn_adaln"


def rmsnorm(x, g):
    xf = x.astype(jnp.float32)
    y = xf * lax.rsqrt(jnp.mean(xf * xf, axis=-1, keepdims=True) + EPS)
    return (y * g.astype(jnp.float32)).astype(x.dtype)


def modulate(h, shift, scale):
    return h * (1 + scale[:, None, :]) + shift[:, None, :]


def causal_dwconv(u, w, b):
    k_width = w.shape[0]
    s = u.shape[1]
    up = jnp.pad(u, ((0, 0), (k_width - 1, 0), (0, 0)))
    y = up[:, 0:s] * w[0]
    for k in range(1, k_width):
        y = y + up[:, k:k + s] * w[k]
    return y + b


def causal_multiscale_pool(h):
    bsz, s, _ = h.shape
    pos = jnp.arange(s)
    outs = []
    for gi, win in enumerate(POOL_WINDOWS):
        hg = h[:, :, gi * POOL_GROUP:(gi + 1) * POOL_GROUP].astype(jnp.float32)
        cs = jnp.cumsum(hg, axis=1)
        prev = jnp.pad(cs, ((0, 0), (win, 0), (0, 0)))[:, :s]
        count = jnp.minimum(pos + 1, win).astype(jnp.float32)
        mean = (cs - prev) / count[None, :, None]
        outs.append((mean - hg).astype(h.dtype))
    return jnp.stack(outs, axis=2)


def pool_mixer(h, pool_w, pool_scale):
    bsz, s, d = h.shape
    p = causal_multiscale_pool(h)
    y = jnp.einsum("bsgc,gce->bsge", p, pool_w).reshape(bsz, s, d)
    return y * pool_scale


def short_conv_mixer(h, bcx_w, conv_w, conv_b, out_w):
    z = h @ bcx_w
    bg, cg, u = jnp.split(z, 3, axis=-1)
    v = causal_dwconv(cg * u, conv_w, conv_b)
    return (bg * v) @ out_w


def conv_ffn(h, up_w, conv_w, conv_b, down_w):
    a = causal_dwconv(h @ up_w, conv_w, conv_b)
    g, v = jnp.split(a, 2, axis=-1)
    return (jax.nn.silu(g) * v) @ down_w


def setup_inputs(seed: int = 0) -> dict:
    key = jax.random.key(seed)
    ks = jax.random.split(key, 20)
    d, f = D_MODEL, D_FF
    n = lambda k, shape, s: jax.random.normal(k, shape, jnp.float32) * s
    return {
        "x": n(ks[0], (BATCH, SEQ, d), 1.0),
        "c": n(ks[1], (BATCH, d), 1.0),
        "ada_w": n(ks[2], (DEPTH, d, 6 * d), 0.1 * d ** -0.5),
        "ada_b": n(ks[3], (DEPTH, 6 * d), 0.02),
        "norm1_g": 1.0 + n(ks[4], (DEPTH, d), 0.02),
        "norm2_g": 1.0 + n(ks[5], (DEPTH, d), 0.02),
        "pool_w": n(ks[6], (N_A, N_POOL_GROUPS, POOL_GROUP, POOL_GROUP), POOL_GROUP ** -0.5),
        "pool_scale": 1.0 + n(ks[7], (N_A, d), 0.02),
        "bcx_w": n(ks[8], (N_B, d, 3 * d), d ** -0.5),
        "sconv_w": n(ks[9], (N_B, CONV_WIDTH, d), CONV_WIDTH ** -0.5),
        "sconv_b": n(ks[10], (N_B, d), 0.02),
        "sout_w": n(ks[11], (N_B, d, d), d ** -0.5),
        "up_w": n(ks[12], (DEPTH, d, 2 * f), d ** -0.5),
        "fconv_w": n(ks[13], (DEPTH, CONV_WIDTH, 2 * f), CONV_WIDTH ** -0.5),
        "fconv_b": n(ks[14], (DEPTH, 2 * f), 0.02),
        "down_w": n(ks[15], (DEPTH, f, d), f ** -0.5),
        "final_g": 1.0 + n(ks[16], (d,), 0.02),
    }


def reference(x, c, ada_w, ada_b, norm1_g, norm2_g, pool_w, pool_scale, bcx_w, sconv_w,
              sconv_b, sout_w, up_w, fconv_w, fconv_b, down_w, final_g):
    for i in range(DEPTH):
        mod = c @ ada_w[i] + ada_b[i]
        sh1, sc1, g1, sh2, sc2, g2 = jnp.split(mod, 6, axis=-1)
        h = modulate(rmsnorm(x, norm1_g[i]), sh1, sc1)
        j = i // N_MIXERS
        if i % N_MIXERS == 0:
            y = pool_mixer(h, pool_w[j], pool_scale[j])
        else:
            y = short_conv_mixer(h, bcx_w[j], sconv_w[j], sconv_b[j], sout_w[j])
        x = x + (1 + g1)[:, None, :] * y
        h = modulate(rmsnorm(x, norm2_g[i]), sh2, sc2)
        y = conv_ffn(h, up_w[i], fconv_w[i], fconv_b[i], down_w[i])
        x = x + (1 + g2)[:, None, :] * y
    return rmsnorm(x, final_g)
```

```cpp
#include <hip/hip_runtime.h>
#include <hip/hip_cooperative_groups.h>
#include <cstdio>
namespace cg = cooperative_groups;

#define LAS __attribute__((address_space(3)))
typedef unsigned short bf16_t;
typedef short bf16x8 __attribute__((ext_vector_type(8)));
typedef float f32x4 __attribute__((ext_vector_type(4)));
typedef unsigned u32x4 __attribute__((ext_vector_type(4)));
typedef unsigned u32x2 __attribute__((ext_vector_type(2)));

constexpr int D = 2048, FF = 5632, NUP = 2 * FF, SEQ = 16384, NBATCH = 2, M = NBATCH * SEQ, MODW = 6 * D;
constexpr float EPS = 1e-6f;

constexpr size_t WS_WPOOL = 0;
constexpr size_t WS_WBCX  = WS_WPOOL + (size_t)2048 * 512 * 2;
constexpr size_t WS_WSOUT = WS_WBCX + (size_t)6144 * 2048 * 2;
constexpr size_t WS_WUP   = WS_WSOUT + (size_t)2048 * 2048 * 2;
constexpr size_t WS_WDOWN = WS_WUP + (size_t)2 * NUP * D * 2;
constexpr size_t WS_MOD   = WS_WDOWN + (size_t)2 * D * FF * 2;
constexpr size_t WS_H     = WS_MOD + (size_t)2 * 2 * MODW * 4;
constexpr size_t WS_ACT   = WS_H + (size_t)M * D * 2;
constexpr size_t WS_PART  = WS_ACT + (size_t)M * FF * 2;
constexpr size_t WS_TAIL  = WS_PART + (size_t)128 * 2 * NUP * 4;
constexpr size_t WS_X     = WS_TAIL + (size_t)128 * 2 * NUP * 4;
constexpr size_t WS_BAR   = WS_X + (size_t)M * D * 2;
constexpr size_t WS_END   = WS_BAR + 16384;

struct Params {
    const float *x, *c, *ada_w, *ada_b, *n1g, *n2g, *pool_w, *pool_scale, *bcx_w, *sconv_w, *sconv_b, *sout_w, *up_w, *fconv_w, *fconv_b, *down_w, *final_g;
    float* out; unsigned char* ws; int ph_lo, ph_hi;
};

__device__ __forceinline__ unsigned cvt_pk_bf16(float lo, float hi) { unsigned r; asm volatile("v_cvt_pk_bf16_f32 %0, %1, %2" : "=v"(r) : "v"(lo), "v"(hi)); return r; }

__device__ __forceinline__ size_t img_off(int row, int col, int K) {
    const int r = row & 127, c = col & 63;
    int ob = (r & 15) * 64 + (c & 31) * 2; ob ^= ((ob >> 9) & 1) << 5;
    const int b = ((r >> 4) * 2 + (c >> 5)) * 1024 + ob;
    return ((size_t)((row >> 7) * (K >> 6) + (col >> 6))) * 8192 + (size_t)(b >> 1);
}
__device__ __forceinline__ int invperm32(int c) { return 16 * ((c >> 2) & 1) + 4 * (c >> 3) + (c & 3); }

namespace pg8 {
constexpr int BM = 256, BK = 64, HALF = 128, HTB = HALF * BK * 2, STAGE_BYTES = 8 * HTB, NXCD = 8, WGM = 8;
__device__ __forceinline__ int lds_byte(int r, int c) { const int st = (r >> 4) * 2 + (c >> 5), rr = r & 15, cc = c & 31, ob = rr * 64 + cc * 2; return st * 1024 + (ob ^ (((ob >> 9) & 1) << 5)); }
__device__ __forceinline__ void stage_rc(int b, int& R, int& C) { const int st = b / 1024, sb = b % 1024, swz = sb ^ (((sb >> 9) & 1) << 5); R = (st >> 1) * 16 + swz / 64; C = (st & 1) * 32 + (swz % 64) / 2; }
__device__ __forceinline__ int perm32(int rho) { const int n = rho >> 4, i = rho & 15; return 8 * (i >> 2) + 4 * n + (i & 3); }

struct Unit { int pm, pn; };
struct Gemm { const bf16_t* A; const bf16_t* Bt; int M, N, K, lda, gshift, gstride; };

struct StaticOrder {
    int nM, nN, nwg, G, c;
    __device__ void init(int M_, int N_, int G_, int c_) { nM = M_ / BM; nN = N_ / BM; nwg = nM * nN; G = G_; c = c_; }
    __device__ bool next(int i, Unit& u) const {
        const long L = (long)i * G + c; if (L >= nwg) return false;
        int wgid = (int)L; { const int q = nwg / NXCD, r = nwg % NXCD, xcd = wgid % NXCD, off = wgid / NXCD; wgid = (xcd < r ? xcd * (q + 1) : r * (q + 1) + (xcd - r) * q) + off; }
        const int nig = WGM * nN, gid = wgid / nig, fm = gid * WGM, gsz = (nM - fm) < WGM ? (nM - fm) : WGM;
        u.pm = fm + ((wgid % nig) % gsz); u.pn = (wgid % nig) / gsz; return true;
    }
};

template <class Epi>
__device__ __forceinline__ void gemm_phase(LAS unsigned char* lds, const Gemm g, const StaticOrder& S, const Epi& E) {
    int tid = threadIdx.x; asm volatile("" : "+v"(tid));
    const int wid = __builtin_amdgcn_readfirstlane(tid >> 6), lane = tid & 63, wr = wid >> 2, wc = wid & 3, fr = lane & 15, fq = lane >> 4;
    const int K = g.K, nt = K / BK;
    const unsigned voff0 = (unsigned)(tid * 16);
    const unsigned hA = (unsigned)(g.lda * 256), hB = (unsigned)(K * 256);
    constexpr int KS = 16384;
    const size_t tstepA = (size_t)BM * g.lda * 2, tstepB = (size_t)BM * K * 2;
    const unsigned lds0 = (unsigned)__builtin_amdgcn_readfirstlane((int)((unsigned)(size_t)lds + (unsigned)wid * 1024u));
    const int aoff = lds_byte(wr * 64 + fr, fq * 8), boff = lds_byte(wc * 32 + fr, fq * 8);
#define PG8_SA(b, h) (((b) * 2 + (h)) * HTB)
#define PG8_SB(b, h) ((4 + (b) * 2 + (h)) * HTB)
#define PG8_STAGE(bufoff, gbase, hoff, imm) do { _Pragma("unroll") for (int _i = 0; _i < 2; ++_i) { unsigned _keep; \
        asm volatile("s_mov_b32 %0, m0\n\ts_mov_b32 m0, %1\n\ts_nop 0\n\tglobal_load_lds_dwordx4 %2, %3\n\ts_mov_b32 m0, %0" \
            : "=&s"(_keep) : "s"(lds0 + (unsigned)((bufoff) + _i * 8192)), "v"(voff0), "s"((const char*)(gbase) + (size_t)(hoff) + (size_t)(_i * 8192)) : "memory"); } } while (0)
#define PG8_LDA(dst, b, h) do { _Pragma("unroll") for (int m = 0; m < 4; ++m) _Pragma("unroll") for (int k = 0; k < 2; ++k) dst[m][k] = *(const LAS bf16x8*)(lds + PG8_SA(b, h) + aoff + m * 2048 + k * 1024); } while (0)
#define PG8_LDB(dst, b, h) do { _Pragma("unroll") for (int n = 0; n < 2; ++n) _Pragma("unroll") for (int k = 0; k < 2; ++k) dst[n][k] = *(const LAS bf16x8*)(lds + PG8_SB(b, h) + boff + n * 2048 + k * 1024); } while (0)
#define PG8_MMA(ai, bj, At, Bt) do { __builtin_amdgcn_s_setprio(1); _Pragma("unroll") for (int m = 0; m < 4; ++m) _Pragma("unroll") for (int n = 0; n < 2; ++n) _Pragma("unroll") for (int k = 0; k < 2; ++k) \
        acc[ai][bj][m][n] = __builtin_amdgcn_mfma_f32_16x16x32_bf16(Bt[n][k], At[m][k], acc[ai][bj][m][n], 0, 0, 0); __builtin_amdgcn_s_setprio(0); } while (0)
#define PG8_WAIT_V(n) asm volatile("s_waitcnt vmcnt(" #n ")" ::: "memory")
#define PG8_WAIT_L(n) asm volatile("s_waitcnt lgkmcnt(" #n ")" ::: "memory")
#define PG8_BAR __builtin_amdgcn_s_barrier()
#define PG8_SCHED __builtin_amdgcn_sched_barrier(0)
    Unit cur, nxt; int ui = 0;
    if (!S.next(0, cur)) return;
    f32x4 acc[2][2][4][2];
#pragma unroll
    for (int a = 0; a < 2; ++a)
#pragma unroll
        for (int b = 0; b < 2; ++b)
#pragma unroll
            for (int m = 0; m < 4; ++m)
#pragma unroll
                for (int n = 0; n < 2; ++n) acc[a][b][m][n] = (f32x4){0.f, 0.f, 0.f, 0.f};
    bf16x8 At[4][2], B0[2][2], B1[2][2];
    const char* cA = (const char*)g.A + (size_t)cur.pm * tstepA + (size_t)(cur.pn >> g.gshift) * g.gstride; const char* cB = (const char*)g.Bt + (size_t)cur.pn * tstepB;
    PG8_STAGE(PG8_SB(0, 0), cB, 0, 0); PG8_STAGE(PG8_SA(0, 0), cA, 0, 0); PG8_STAGE(PG8_SB(0, 1), cB, hB, 0); PG8_STAGE(PG8_SA(0, 1), cA, hA, 0);
    if (wr == 1) PG8_BAR;
    PG8_WAIT_V(4); PG8_BAR;
    PG8_STAGE(PG8_SB(1, 0), cB + KS, 0, 0); PG8_STAGE(PG8_SA(1, 0), cA + KS, 0, 0); PG8_STAGE(PG8_SB(1, 1), cB + KS, hB, 0);
    PG8_WAIT_V(6); PG8_BAR;
    for (;;) {
        const bool has_next = S.next(ui + 1, nxt);
        const char* nA = has_next ? (const char*)g.A + (size_t)nxt.pm * tstepA + (size_t)(nxt.pn >> g.gshift) * g.gstride : cA;
        const char* nB = has_next ? (const char*)g.Bt + (size_t)nxt.pn * tstepB : cB;
        for (int t = 0; t < nt; t += 2) {
            const bool last = (t == nt - 2);
            if (last) E.pre(cur, wid, lane, (unsigned)(size_t)(lds + STAGE_BYTES));
            const char* aT = cA + (size_t)t * KS;
            const char* a2 = last ? nA : aT + 2 * KS; const char* b2 = last ? nB : cB + (size_t)(t + 2) * KS;
            PG8_LDB(B0, 0, 0); PG8_SCHED; PG8_LDA(At, 0, 0); PG8_STAGE(PG8_SA(1, 1), aT + KS, hA, 0);
            PG8_WAIT_L(8); PG8_BAR; PG8_WAIT_L(0); PG8_MMA(0, 0, At, B0); PG8_BAR; PG8_SCHED;
            PG8_LDB(B1, 0, 1); PG8_STAGE(PG8_SB(0, 0), b2, 0, 0);
            PG8_BAR; PG8_WAIT_L(0); PG8_MMA(0, 1, At, B1); PG8_BAR;
            PG8_LDA(At, 0, 1); PG8_STAGE(PG8_SA(0, 0), a2, 0, 0);
            PG8_BAR; PG8_WAIT_L(0); PG8_MMA(1, 0, At, B0); PG8_BAR; PG8_SCHED;
            PG8_STAGE(PG8_SB(0, 1), b2, hB, 0);
            PG8_WAIT_V(6); PG8_BAR; PG8_MMA(1, 1, At, B1); PG8_BAR;
            PG8_LDB(B0, 1, 0); PG8_SCHED; PG8_LDA(At, 1, 0); PG8_STAGE(PG8_SA(0, 1), a2, hA, 0);
            PG8_WAIT_L(8); PG8_BAR; PG8_WAIT_L(0); PG8_MMA(0, 0, At, B0); PG8_BAR; PG8_SCHED;
            PG8_LDB(B1, 1, 1); PG8_STAGE(PG8_SB(1, 0), b2 + KS, 0, 0);
            PG8_BAR; PG8_WAIT_L(0); PG8_MMA(0, 1, At, B1); PG8_BAR;
            PG8_LDA(At, 1, 1); PG8_STAGE(PG8_SA(1, 0), a2 + KS, 0, 0);
            PG8_BAR; PG8_WAIT_L(0); PG8_MMA(1, 0, At, B0); PG8_BAR; PG8_SCHED;
            PG8_STAGE(PG8_SB(1, 1), b2 + KS, hB, 0);
            PG8_WAIT_V(6); PG8_BAR; PG8_MMA(1, 1, At, B1); PG8_BAR;
        }
        E(acc, cur, wr, wc, fr, fq, lds + STAGE_BYTES);
        if (!has_next) break;
#pragma unroll
        for (int a = 0; a < 2; ++a)
#pragma unroll
            for (int b = 0; b < 2; ++b)
#pragma unroll
                for (int m = 0; m < 4; ++m)
#pragma unroll
                    for (int n = 0; n < 2; ++n) acc[a][b][m][n] = (f32x4){0.f, 0.f, 0.f, 0.f};
        cur = nxt; cA = nA; cB = nB; ++ui;
    }
    PG8_WAIT_V(0);
    if (wr == 0) PG8_BAR;
    PG8_BAR;
#undef PG8_SA
#undef PG8_SB
#undef PG8_STAGE
#undef PG8_LDA
#undef PG8_LDB
#undef PG8_MMA
#undef PG8_WAIT_V
#undef PG8_WAIT_L
#undef PG8_SCHED
}

template <bool IN_F32> struct EpiRes {
    static constexpr bool PERM = true;
    const void* in; bf16_t* out; const float* gate; const float* cs;
    __device__ __forceinline__ void pre(const Unit&, int, int, unsigned) const {}
    __device__ __forceinline__ void operator()(f32x4 (&acc)[2][2][4][2], const Unit& u, int wr, int wc, int fr, int fq, LAS unsigned char*) const {
        const int b = u.pm >> 6;
        const int col0 = u.pn * BM + wc * 32 + 8 * fq;
        const size_t off0 = (size_t)(u.pm * BM + wr * 64 + fr) * D + col0;
        f32x4 sc[2][2];
#pragma unroll
        for (int bj = 0; bj < 2; ++bj)
#pragma unroll
            for (int n = 0; n < 2; ++n) { f32x4 gt = *(const f32x4*)(gate + (size_t)b * MODW + col0 + bj * HALF + n * 4); sc[bj][n] = gt + 1.0f;
                if (cs) sc[bj][n] *= *(const f32x4*)(cs + col0 + bj * HALF + n * 4); }
        if (IN_F32) {
#pragma unroll
            for (int ai = 0; ai < 2; ++ai) {
                f32x4 r[4][2][2];
#pragma unroll
                for (int m = 0; m < 4; ++m)
#pragma unroll
                    for (int bj = 0; bj < 2; ++bj)
#pragma unroll
                        for (int n = 0; n < 2; ++n) r[m][bj][n] = *(const f32x4*)((const float*)in + off0 + (size_t)(ai * HALF + m * 16) * D + bj * HALF + n * 4);
#pragma unroll
                for (int m = 0; m < 4; ++m)
#pragma unroll
                    for (int bj = 0; bj < 2; ++bj) { const f32x4 r0 = r[m][bj][0] + sc[bj][0] * acc[ai][bj][m][0], r1 = r[m][bj][1] + sc[bj][1] * acc[ai][bj][m][1];
                        u32x4 w; w.x = cvt_pk_bf16(r0[0], r0[1]); w.y = cvt_pk_bf16(r0[2], r0[3]); w.z = cvt_pk_bf16(r1[0], r1[1]); w.w = cvt_pk_bf16(r1[2], r1[3]);
                        *(u32x4*)(out + off0 + (size_t)(ai * HALF + m * 16) * D + bj * HALF) = w; }
                asm volatile("" ::: "memory");
            }
        } else {
            u32x4 xb[2][4][2];
#pragma unroll
            for (int ai = 0; ai < 2; ++ai)
#pragma unroll
                for (int m = 0; m < 4; ++m)
#pragma unroll
                    for (int bj = 0; bj < 2; ++bj) xb[ai][m][bj] = *(const u32x4*)((const bf16_t*)in + off0 + (size_t)(ai * HALF + m * 16) * D + bj * HALF);
#pragma unroll
            for (int ai = 0; ai < 2; ++ai)
#pragma unroll
                for (int m = 0; m < 4; ++m)
#pragma unroll
                    for (int bj = 0; bj < 2; ++bj) { const u32x4 x = xb[ai][m][bj];
                        f32x4 r0 = (f32x4){__uint_as_float(x.x << 16), __uint_as_float(x.x & 0xffff0000u), __uint_as_float(x.y << 16), __uint_as_float(x.y & 0xffff0000u)};
                        f32x4 r1 = (f32x4){__uint_as_float(x.z << 16), __uint_as_float(x.z & 0xffff0000u), __uint_as_float(x.w << 16), __uint_as_float(x.w & 0xffff0000u)};
                        r0 += sc[bj][0] * acc[ai][bj][m][0]; r1 += sc[bj][1] * acc[ai][bj][m][1];
                        u32x4 w; w.x = cvt_pk_bf16(r0[0], r0[1]); w.y = cvt_pk_bf16(r0[2], r0[3]); w.z = cvt_pk_bf16(r1[0], r1[1]); w.w = cvt_pk_bf16(r1[2], r1[3]);
                        *(u32x4*)(out + off0 + (size_t)(ai * HALF + m * 16) * D + bj * HALF) = w; }
        }
    }
};
struct EpiBf16 {
    static constexpr bool PERM = true;
    bf16_t* O; int ldc;
    __device__ __forceinline__ void pre(const Unit&, int, int, unsigned) const {}
    __device__ __forceinline__ void operator()(f32x4 (&acc)[2][2][4][2], const Unit& u, int wr, int wc, int fr, int fq, LAS unsigned char*) const {
        const int row0 = u.pm * BM + wr * 64 + fr, col0 = u.pn * BM + wc * 32 + 8 * fq;
#pragma unroll
        for (int ai = 0; ai < 2; ++ai)
#pragma unroll
            for (int m = 0; m < 4; ++m) { bf16_t* rowp = O + (size_t)(row0 + ai * HALF + m * 16) * ldc + col0;
#pragma unroll
                for (int bj = 0; bj < 2; ++bj) { const f32x4 v0 = acc[ai][bj][m][0], v1 = acc[ai][bj][m][1];
                    u32x4 w; w.x = cvt_pk_bf16(v0[0], v0[1]); w.y = cvt_pk_bf16(v0[2], v0[3]); w.z = cvt_pk_bf16(v1[0], v1[1]); w.w = cvt_pk_bf16(v1[2], v1[3]);
                    *(u32x4*)(rowp + bj * HALF) = w; } }
    }
};

__device__ __forceinline__ float dpp_ror1(float s) { return __int_as_float(__builtin_amdgcn_update_dpp(0, __float_as_int(s), 0x121, 0xf, 0xf, false)); }
__device__ __forceinline__ float dpp_ror2(float s) { return __int_as_float(__builtin_amdgcn_update_dpp(0, __float_as_int(s), 0x122, 0xf, 0xf, false)); }
__device__ __forceinline__ float dpp_shr1(float old, float s) { return __int_as_float(__builtin_amdgcn_update_dpp(__float_as_int(old), __float_as_int(s), 0x111, 0xf, 0xf, false)); }
__device__ __forceinline__ float dpp_shr2(float old, float s) { return __int_as_float(__builtin_amdgcn_update_dpp(__float_as_int(old), __float_as_int(s), 0x112, 0xf, 0xf, false)); }
__device__ __forceinline__ float conv1(float cur, float prv, float w0, float w1, float w2, float b) {
    float r, t1, t2;
    asm volatile(
        "s_nop 1\n\t"
        "v_mov_b32_dpp %1, %4 row_ror:1 row_mask:0xf bank_mask:0xf\n\t"
        "v_mov_b32_dpp %2, %4 row_ror:2 row_mask:0xf bank_mask:0xf\n\t"
        "v_fma_f32 %0, %7, %3, %8\n\t"
        "v_mov_b32_dpp %1, %3 row_shr:1 row_mask:0xf bank_mask:0xf\n\t"
        "v_mov_b32_dpp %2, %3 row_shr:2 row_mask:0xf bank_mask:0xf\n\t"
        "v_fmac_f32 %0, %6, %1\n\t"
        "v_fmac_f32 %0, %5, %2\n\t"
        : "=&v"(r), "=&v"(t1), "=&v"(t2) : "v"(cur), "v"(prv), "v"(w0), "v"(w1), "v"(w2), "v"(b));
    return r;
}
__device__ __forceinline__ f32x4 conv3(const f32x4 cur, const f32x4 prv, const f32x4 w0, const f32x4 w1, const f32x4 w2, const f32x4 bb) {
    f32x4 r;
#pragma unroll
    for (int j = 0; j < 4; ++j) r[j] = conv1(cur[j], prv[j], w0[j], w1[j], w2[j], bb[j]);
    return r;
}
__device__ __forceinline__ float silu_f(float g) { return g * __builtin_amdgcn_rcpf(1.0f + __builtin_amdgcn_exp2f(-1.44269504089f * g)); }

template <int MODE> struct EpiConv {
    static constexpr bool PERM = true;
    const float* cw; const float* cb; int C; int voff;
    bf16_t* O; int ldo; const bf16_t* BG; float* PART; float* TAIL;
    __device__ __forceinline__ void pre(const Unit& u, int wid, int lane, unsigned ldsx) const {
        if (wid < 4) {
            const int c = lane * 4, s = c >> 7;
            const unsigned vo = (unsigned)(((MODE == 0 && s) ? voff : 0) + (c & 127)) * 4u;
            const char* base = (const char*)((wid < 3 ? cw + (size_t)wid * C : cb) + 128 * u.pn);
            unsigned keep;
            asm volatile("s_mov_b32 %0, m0\n\ts_mov_b32 m0, %1\n\ts_nop 0\n\tglobal_load_lds_dwordx4 %2, %3\n\ts_mov_b32 m0, %0"
                : "=&s"(keep) : "s"(ldsx + 8192u + (unsigned)wid * 1024u), "v"(vo), "s"(base) : "memory");
        }
    }
    __device__ __forceinline__ void operator()(f32x4 (&acc)[2][2][4][2], const Unit& u, int wr, int wc, int fr, int fq, LAS unsigned char* xl) const {
        constexpr int NS = MODE == 0 ? 2 : 1;
        const int chl = 32 * wc + 8 * fq, ch0 = 128 * u.pn + chl;
        LAS float* bnd = (LAS float*)xl;
        LAS float* wt = (LAS float*)(xl + 8192);
        asm volatile("s_waitcnt vmcnt(16)" ::: "memory");
        if (MODE == 1) {
#pragma unroll
            for (int ai = 0; ai < 2; ++ai)
#pragma unroll
                for (int m = 0; m < 4; ++m)
#pragma unroll
                    for (int n = 0; n < 2; ++n) acc[ai][0][m][n] *= acc[ai][1][m][n];
        }
        if (fr >= 14) {
#pragma unroll
            for (int ai = 0; ai < 2; ++ai)
#pragma unroll
                for (int s = 0; s < NS; ++s)
#pragma unroll
                    for (int n = 0; n < 2; ++n) *(LAS f32x4*)(bnd + (((ai * 2 + wr) * 2 + (fr - 14)) * 256 + s * 128 + chl + 4 * n)) = acc[ai][s][3][n];
            if (wr == 1) {
#pragma unroll
                for (int s = 0; s < NS; ++s)
#pragma unroll
                    for (int n = 0; n < 2; ++n) *(f32x4*)(TAIL + (size_t)(u.pm * 2 + (fr - 14)) * C + (s ? voff : 0) + ch0 + 4 * n) = acc[1][s][3][n];
            }
        }
        asm volatile("s_waitcnt lgkmcnt(0)" ::: "memory"); PG8_BAR; asm volatile("" ::: "memory"); PG8_BAR; asm volatile("" ::: "memory");
        u32x4 bgv[2][4];
        if (MODE == 1) {
#pragma unroll
            for (int ai = 0; ai < 2; ++ai)
#pragma unroll
                for (int m = 0; m < 4; ++m) bgv[ai][m] = *(const u32x4*)(BG + (size_t)(u.pm * BM + ai * HALF + wr * 64 + m * 16 + fr) * D + ch0);
        }
        f32x4 W0[NS][2], W1[NS][2], W2[NS][2], BB[NS][2];
#pragma unroll
        for (int s = 0; s < NS; ++s)
#pragma unroll
            for (int n = 0; n < 2; ++n) { const int lc = s * 128 + chl + 4 * n;
                W0[s][n] = *(const LAS f32x4*)(wt + lc); W1[s][n] = *(const LAS f32x4*)(wt + 256 + lc); W2[s][n] = *(const LAS f32x4*)(wt + 512 + lc); BB[s][n] = *(const LAS f32x4*)(wt + 768 + lc); }
#pragma unroll
        for (int ai = 0; ai < 2; ++ai) {
            const int blk = ai * 2 + wr;
            f32x4 pg[NS][2];
#pragma unroll
            for (int s = 0; s < NS; ++s)
#pragma unroll
                for (int n = 0; n < 2; ++n) pg[s][n] = (f32x4){0.f, 0.f, 0.f, 0.f};
            if (blk > 0) {
#pragma unroll
                for (int s = 0; s < NS; ++s)
#pragma unroll
                    for (int n = 0; n < 2; ++n) pg[s][n] = *(const LAS f32x4*)(bnd + (((blk - 1) * 2 + (fr & 1)) * 256 + s * 128 + chl + 4 * n));
            }
#pragma unroll
            for (int m = 3; m >= 0; --m) {
#pragma unroll
                for (int s = 0; s < NS; ++s)
#pragma unroll
                    for (int n = 0; n < 2; ++n) acc[ai][s][m][n] = conv3(acc[ai][s][m][n], m == 0 ? pg[s][n] : acc[ai][s][m - 1][n], W0[s][n], W1[s][n], W2[s][n], BB[s][n]);
                if (ai == 0 && m == 0) {
                    if (wr == 0 && fr < 2) {
#pragma unroll
                        for (int s = 0; s < NS; ++s)
#pragma unroll
                            for (int n = 0; n < 2; ++n) *(f32x4*)(PART + (size_t)(u.pm * 2 + fr) * C + (s ? voff : 0) + ch0 + 4 * n) = acc[0][s][0][n];
                    }
                }
                const size_t row = (size_t)(u.pm * BM + ai * HALF + wr * 64 + m * 16 + fr);
                f32x4 o0, o1;
                if (MODE == 0) {
#pragma unroll
                    for (int j = 0; j < 4; ++j) { o0[j] = silu_f(acc[ai][0][m][0][j]) * acc[ai][1][m][0][j]; o1[j] = silu_f(acc[ai][0][m][1][j]) * acc[ai][1][m][1][j]; }
                } else {
                    const u32x4 bg = bgv[ai][m];
                    o0[0] = __uint_as_float(bg.x << 16) * acc[ai][0][m][0][0]; o0[1] = __uint_as_float(bg.x & 0xffff0000u) * acc[ai][0][m][0][1];
                    o0[2] = __uint_as_float(bg.y << 16) * acc[ai][0][m][0][2]; o0[3] = __uint_as_float(bg.y & 0xffff0000u) * acc[ai][0][m][0][3];
                    o1[0] = __uint_as_float(bg.z << 16) * acc[ai][0][m][1][0]; o1[1] = __uint_as_float(bg.z & 0xffff0000u) * acc[ai][0][m][1][1];
                    o1[2] = __uint_as_float(bg.w << 16) * acc[ai][0][m][1][2]; o1[3] = __uint_as_float(bg.w & 0xffff0000u) * acc[ai][0][m][1][3];
                }
                u32x4 w; w.x = cvt_pk_bf16(o0[0], o0[1]); w.y = cvt_pk_bf16(o0[2], o0[3]); w.z = cvt_pk_bf16(o1[0], o1[1]); w.w = cvt_pk_bf16(o1[2], o1[3]);
                *(u32x4*)(O + img_off((int)row, ch0, ldo)) = w;
                __builtin_amdgcn_sched_barrier(0);
            }
        }
    }
};
#undef PG8_BAR
}

__device__ __forceinline__ float wave_sum(float v) {
#pragma unroll
    for (int o = 32; o >= 1; o >>= 1) v += __shfl_xor(v, o);
    return v;
}

__device__ void p0_gemv(const Params& p, int item, LAS float* lds) {
    const int tid = threadIdx.x;
    const int l = item / 192, n0 = (item % 192) * 64;
    LAS float* cs = lds; LAS float* red = lds + 4096;
    for (int i = tid; i < 4096; i += 512) cs[i] = p.c[i];
    __syncthreads();
    const int l4 = tid & 15, kg = tid >> 4;
    const float* w = p.ada_w + (size_t)l * D * MODW + n0 + l4 * 4;
    f32x4 a0 = (f32x4){0.f, 0.f, 0.f, 0.f}, a1 = a0;
#pragma unroll 8
    for (int kk = 0; kk < 64; ++kk) { const int k = kg * 64 + kk; const f32x4 wv = *(const f32x4*)(w + (size_t)k * MODW); a0 += wv * cs[k]; a1 += wv * cs[2048 + k]; }
    *(LAS f32x4*)(red + (kg * 2 + 0) * 64 + l4 * 4) = a0; *(LAS f32x4*)(red + (kg * 2 + 1) * 64 + l4 * 4) = a1;
    __syncthreads();
    if (tid < 128) { const int b = tid >> 6, n = tid & 63; float s = 0.f;
        for (int g = 0; g < 32; ++g) s += red[(g * 2 + b) * 64 + n];
        s += p.ada_b[l * MODW + n0 + n];
        ((float*)(p.ws + WS_MOD))[(size_t)(l * 2 + b) * MODW + n0 + n] = s; }
    __syncthreads();
}
__device__ void tconv_tile(const float* src, int lds_, int k0, int n0, bf16_t* dst, int ldd, int drow0, bool perm, LAS float* t) {
    const int tid = threadIdx.x;
#pragma unroll
    for (int i = 0; i < 2; ++i) { const int idx = tid + i * 512, r = idx >> 4, c4 = idx & 15;
        const f32x4 v = *(const f32x4*)(src + (size_t)(k0 + r) * lds_ + n0 + c4 * 4);
        LAS float* q = t + r * 65 + c4 * 4; q[0] = v[0]; q[1] = v[1]; q[2] = v[2]; q[3] = v[3]; }
    __syncthreads();
    const int n = tid >> 3, kc = tid & 7;
    float f[8];
#pragma unroll
    for (int i = 0; i < 8; ++i) f[i] = t[(kc * 8 + i) * 65 + n];
    u32x4 w; w.x = cvt_pk_bf16(f[0], f[1]); w.y = cvt_pk_bf16(f[2], f[3]); w.z = cvt_pk_bf16(f[4], f[5]); w.w = cvt_pk_bf16(f[6], f[7]);
    { const int R = drow0 + n, Rs = perm ? ((R & ~31) + invperm32(R & 31)) : R; *(u32x4*)(dst + img_off(Rs, k0 + kc * 8, ldd)) = w; }
    __syncthreads();
}
__device__ __forceinline__ int unit_row(int ch, int second) { return 256 * (ch >> 7) + (second ? 128 : 0) + (ch & 127); }
__device__ void phase0(const Params& p, LAS unsigned char* lds) {
    LAS float* fl = (LAS float*)lds;
    constexpr int N_GEMV = 384, T_POOL = 256, T_BCX = 3072, T_SOUT = 1024, T_UP = 5632, T_DOWN = 2816;
    constexpr int TOTAL = N_GEMV + T_POOL + T_BCX + T_SOUT + 2 * T_UP + 2 * T_DOWN;
    for (int it = blockIdx.x; it < TOTAL; it += gridDim.x) {
        int i = it;
        if (i < N_GEMV) { p0_gemv(p, i, fl); continue; }
        i -= N_GEMV;
        if (i < T_POOL) { const int g = i >> 6, rem = i & 63, kt = rem >> 3, nt = rem & 7;
            tconv_tile(p.pool_w + (size_t)g * 512 * 512, 512, kt * 64, nt * 64, (bf16_t*)(p.ws + WS_WPOOL), 512, g * 512 + nt * 64, true, fl); continue; }
        i -= T_POOL;
        if (i < T_BCX) { const int kt = i / 96, nt = i % 96, n0 = nt * 64;
            const int drow0 = n0 < 2048 ? n0 : (n0 < 4096 ? 2048 + unit_row(n0 - 2048, 0) : 2048 + unit_row(n0 - 4096, 1));
            tconv_tile(p.bcx_w, 3 * D, kt * 64, n0, (bf16_t*)(p.ws + WS_WBCX), D, drow0, true, fl); continue; }
        i -= T_BCX;
        if (i < T_SOUT) { const int kt = i >> 5, nt = i & 31;
            tconv_tile(p.sout_w, D, kt * 64, nt * 64, (bf16_t*)(p.ws + WS_WSOUT), D, nt * 64, true, fl); continue; }
        i -= T_SOUT;
        if (i < 2 * T_UP) { const int l = i / T_UP, j = i % T_UP, kt = j / 176, nt = j % 176, n0 = nt * 64;
            const int drow0 = n0 < FF ? unit_row(n0, 0) : unit_row(n0 - FF, 1);
            tconv_tile(p.up_w + (size_t)l * D * NUP, NUP, kt * 64, n0, (bf16_t*)(p.ws + WS_WUP) + (size_t)l * NUP * D, D, drow0, true, fl); continue; }
        i -= 2 * T_UP;
        { const int l = i / T_DOWN, j = i % T_DOWN, kt = j >> 5, nt = j & 31;
            tconv_tile(p.down_w + (size_t)l * FF * D, D, kt * 64, nt * 64, (bf16_t*)(p.ws + WS_WDOWN) + (size_t)l * D * FF, FF, nt * 64, true, fl); }
    }
}

template <int W>
__device__ __forceinline__ void pool_chunk(const float* x, bf16_t* P, const LAS float* rs  , const f32x4 gs, const f32x4 sh, size_t r0, bool has_halo, int tid) {
    f32x4 ring[W];
#pragma unroll
    for (int j = 0; j < W; ++j) ring[j] = (f32x4){0.f, 0.f, 0.f, 0.f};
    f32x4 s = (f32x4){0.f, 0.f, 0.f, 0.f};
    const float* xp = x + r0 * D + tid * 4;
    if (has_halo) {
#pragma unroll
        for (int j = 0; j < W - 1; ++j) { const int t = -(W - 1) + j; const f32x4 h = *(const f32x4*)(xp + (long)t * D) * rs[t + 15] * gs + sh; ring[j] = h; s += h; }
    }
    for (int i0 = 0; i0 < 128; i0 += 16) {
        f32x4 xv[16];
#pragma unroll
        for (int jj = 0; jj < 16; ++jj) xv[jj] = *(const f32x4*)(xp + (size_t)(i0 + jj) * D);
#pragma unroll
        for (int jj = 0; jj < 16; ++jj) { const int i = i0 + jj; constexpr int dummy = 0; (void)dummy;
            const int slot = (W - 1 + jj) % W;
            const f32x4 h = xv[jj] * rs[i + 15] * gs + sh;
            s += h - ring[slot]; ring[slot] = h;
            const float inv = has_halo ? (1.0f / W) : (1.0f / (float)((i + 1) < W ? (i + 1) : W));
            const f32x4 o = s * inv - h;
            u32x2 w; w.x = cvt_pk_bf16(o[0], o[1]); w.y = cvt_pk_bf16(o[2], o[3]);
            *(u32x2*)(P + img_off((int)(r0 + i), tid * 4, D)) = w; }
    }
}
__device__ void phase1(const Params& p, LAS unsigned char* lds) {
    LAS float* rs = (LAS float*)lds;
    const int tid = threadIdx.x, wave = tid >> 6, lane = tid & 63;
    const float* mod = (const float*)(p.ws + WS_MOD);
    bf16_t* P = (bf16_t*)(p.ws + WS_H);
    for (int it = blockIdx.x; it < M / 128; it += gridDim.x) {
        const size_t r0 = (size_t)it * 128; const int b = (int)(r0 / SEQ); const bool has_halo = (r0 % SEQ) != 0;
        for (int t = (has_halo ? -15 : 0) + wave; t < 128; t += 8) {
            const float* xr = p.x + (r0 + t) * D + lane * 4; float ss = 0.f;
#pragma unroll
            for (int i = 0; i < 8; ++i) { const f32x4 v = *(const f32x4*)(xr + i * 256); ss += v[0] * v[0] + v[1] * v[1] + v[2] * v[2] + v[3] * v[3]; }
            ss = wave_sum(ss);
            if (lane == 0) rs[t + 15] = 1.0f / sqrtf(ss * (1.0f / D) + EPS);
        }
        __syncthreads();
        const f32x4 g4 = *(const f32x4*)(p.n1g + tid * 4);
        const f32x4 sc = *(const f32x4*)(mod + (size_t)b * MODW + 1 * D + tid * 4), sh = *(const f32x4*)(mod + (size_t)b * MODW + 0 * D + tid * 4);
        const f32x4 gs = g4 * (sc + 1.0f);
        const int grp = tid >> 7;
        if (grp == 0) pool_chunk<2>(p.x, P, rs, gs, sh, r0, has_halo, tid);
        else if (grp == 1) pool_chunk<4>(p.x, P, rs, gs, sh, r0, has_halo, tid);
        else if (grp == 2) pool_chunk<8>(p.x, P, rs, gs, sh, r0, has_halo, tid);
        else pool_chunk<16>(p.x, P, rs, gs, sh, r0, has_halo, tid);
        __syncthreads();
    }
}

template <bool FINAL>
__device__ void norm_phase(const bf16_t* X, void* dst, const float* gvec, const float* mod_sh, const float* mod_sc) {
    int tid = threadIdx.x; asm volatile("" : "+v"(tid));
    const int wave = tid >> 6, lane = tid & 63;
    for (int c = blockIdx.x * 8 + wave; c < M / 16; c += gridDim.x * 8) {
        const size_t row0 = (size_t)c * 16; const int b = (int)(row0 / SEQ);
        f32x4 gs[8], sh[8];
#pragma unroll
        for (int i = 0; i < 8; ++i) { const int col = i * 256 + lane * 4; gs[i] = *(const f32x4*)(gvec + col);
            if (!FINAL) { gs[i] *= (*(const f32x4*)(mod_sc + (size_t)b * MODW + col) + 1.0f); sh[i] = *(const f32x4*)(mod_sh + (size_t)b * MODW + col); } }
        for (int r = 0; r < 16; r += 2) {
            u32x2 xb[2][8];
#pragma unroll
            for (int h = 0; h < 2; ++h)
#pragma unroll
                for (int i = 0; i < 8; ++i) xb[h][i] = *(const u32x2*)(X + (row0 + r + h) * D + lane * 4 + i * 256);
#pragma unroll
            for (int h = 0; h < 2; ++h) {
                f32x4 v[8]; float ss = 0.f;
#pragma unroll
                for (int i = 0; i < 8; ++i) { const u32x2 x = xb[h][i];
                    v[i] = (f32x4){__uint_as_float(x.x << 16), __uint_as_float(x.x & 0xffff0000u), __uint_as_float(x.y << 16), __uint_as_float(x.y & 0xffff0000u)};
                    ss += v[i][0] * v[i][0] + v[i][1] * v[i][1] + v[i][2] * v[i][2] + v[i][3] * v[i][3]; }
                ss = wave_sum(ss);
                const float rstd = 1.0f / sqrtf(ss * (1.0f / D) + EPS);
#pragma unroll
                for (int i = 0; i < 8; ++i) { const int col = i * 256 + lane * 4;
                    if (FINAL) { __builtin_nontemporal_store(v[i] * rstd * gs[i], (f32x4*)((float*)dst + (row0 + r + h) * D + col)); }
                    else { const f32x4 hh = v[i] * rstd * gs[i] + sh[i]; u32x2 w; w.x = cvt_pk_bf16(hh[0], hh[1]); w.y = cvt_pk_bf16(hh[2], hh[3]);
                        *(u32x2*)((bf16_t*)dst + img_off((int)(row0 + r + h), col, D)) = w; } }
            }
        }
    }
}

template <int MODE>
__device__ void fixup_tile(int pm, const float* cw, int C, int voff, int nch, const float* PART, const float* TAIL, bf16_t* O, int ldo, const bf16_t* BG) {
    const int nq = nch / 4;
    int tid = threadIdx.x; asm volatile("" : "+v"(tid));
    for (int i = tid; i < 2 * nq; i += 512) {
        const int r = i / nq, ch = (i - r * nq) * 4;
        const size_t row = (size_t)pm * 256 + r;
        f32x4 val[2];
#pragma unroll
        for (int s = 0; s < (MODE == 0 ? 2 : 1); ++s) {
            const int co = (s ? voff : 0) + ch;
            f32x4 a = *(const f32x4*)(PART + (size_t)(pm * 2 + r) * C + co);
            if ((pm & 63) != 0) {
                const f32x4 t1 = *(const f32x4*)(TAIL + (size_t)((pm - 1) * 2 + 1) * C + co);
                const f32x4 w0 = *(const f32x4*)(cw + co);
                if (r == 0) { const f32x4 t2 = *(const f32x4*)(TAIL + (size_t)((pm - 1) * 2 + 0) * C + co); const f32x4 w1 = *(const f32x4*)(cw + C + co); a += w1 * t1 + w0 * t2; }
                else a += w0 * t1;
            }
            val[s] = a;
        }
        f32x4 o;
        if (MODE == 0) {
#pragma unroll
            for (int j = 0; j < 4; ++j) o[j] = pg8::silu_f(val[0][j]) * val[1][j];
        } else {
            const u32x2 bg = *(const u32x2*)(BG + row * D + ch);
            o[0] = __uint_as_float(bg.x << 16) * val[0][0]; o[1] = __uint_as_float(bg.x & 0xffff0000u) * val[0][1];
            o[2] = __uint_as_float(bg.y << 16) * val[0][2]; o[3] = __uint_as_float(bg.y & 0xffff0000u) * val[0][3];
        }
        u32x2 w; w.x = cvt_pk_bf16(o[0], o[1]); w.y = cvt_pk_bf16(o[2], o[3]);
        *(u32x2*)(O + img_off((int)row, ch, ldo)) = w;
    }
}
template <int MODE>
__device__ void fixup_mine(const pg8::StaticOrder& S, const float* cw, int C, int voff, int nch, const float* PART, const float* TAIL, bf16_t* O, int ldo, const bf16_t* BG) {
    pg8::Unit u; int last_pm = -1;
    for (int i = 0; S.next(i, u); ++i) { if (u.pm != last_pm) fixup_tile<MODE>(u.pm, cw, C, voff, nch, PART, TAIL, O, ldo, BG); last_pm = u.pm; }
    asm volatile("s_waitcnt vmcnt(0)" ::: "memory");
    __syncthreads();
}

#define XB_TMO      128
#define XB_XCNT(j)  (256  + 64 * (j))
#define XB_XSUB(j)  (1280 + 64 * (j))
#define XB_XGEN(j)  (2304 + 64 * (j))
#define XB_TOP      3328
#define XB_TOPGEN   3392
#define XCD_BAR_WORDS 3456
#define XB_SPIN_CAP (1u << 22)
__device__ __forceinline__ unsigned xb_ld(unsigned* p)              { return __hip_atomic_load(p, __ATOMIC_RELAXED, __HIP_MEMORY_SCOPE_AGENT); }
__device__ __forceinline__ unsigned xb_add(unsigned* p, unsigned v) { return __hip_atomic_fetch_add(p, v, __ATOMIC_RELAXED, __HIP_MEMORY_SCOPE_AGENT); }
__device__ __forceinline__ unsigned xb_xcc_id() { return (unsigned)__builtin_amdgcn_s_getreg((3 << 11) | 20) & 0xFu; }
#define XB_SPIN(cond, bar) do { unsigned _sp = 0; while (cond) { __builtin_amdgcn_s_sleep(1); \
    if ((++_sp & 255u) == 0u) { if (xb_ld(&(bar)[XB_TMO])) break; if (_sp > XB_SPIN_CAP) { atomicAdd(&(bar)[XB_TMO], 1u); break; } } } } while (0)
struct XcdBarrier { unsigned* bar; unsigned x; volatile LAS unsigned* st; };
__device__ __forceinline__ XcdBarrier xcd_barrier_post(unsigned* bar, volatile LAS unsigned* st) {
    XcdBarrier b; b.bar = bar; b.x = xb_xcc_id(); b.st = st;
    if (threadIdx.x == 0) (void)xb_add(&bar[XB_XCNT(b.x)], 1u);
    return b;
}
__device__ __forceinline__ void xcd_barrier_complete(unsigned* bar, unsigned x, unsigned& nloc, unsigned& nx) {
    const unsigned G = gridDim.x * gridDim.y * gridDim.z;
    unsigned sum, cnt, mine, sp = 0u;
    for (;;) {
        sum = 0u; cnt = 0u; mine = 0u;
#pragma unroll
        for (unsigned j = 0; j < 16; ++j) { const unsigned c = xb_ld(&bar[XB_XCNT(j)]); sum += c; cnt += (c > 0u) ? 1u : 0u; mine = (j == x) ? c : mine; }
        if (sum == G) break;
        __builtin_amdgcn_s_sleep(1);
        if ((++sp & 255u) == 0u) { if (xb_ld(&bar[XB_TMO])) break; if (sp > XB_SPIN_CAP) { atomicAdd(&bar[XB_TMO], 1u); break; } }
    }
    nloc = mine > 0u ? mine : 1u; nx = cnt > 0u ? cnt : 1u;
}
__device__ __forceinline__ void xcd_barrier(const XcdBarrier& b) {
    asm volatile("s_waitcnt vmcnt(0)" ::: "memory");
    __syncthreads();
    if (threadIdx.x == 0) {
        unsigned* bar = b.bar;
        __builtin_amdgcn_s_waitcnt(0);
        unsigned nloc = b.st[0], nx = b.st[1];
        if (nloc == 0u) { xcd_barrier_complete(bar, b.x, nloc, nx); b.st[0] = nloc; b.st[1] = nx; }
        const unsigned old = xb_add(&bar[XB_XSUB(b.x)], 1u);
        const unsigned gen = old / nloc;
        if (old + 1u == (gen + 1u) * nloc) {
            __builtin_amdgcn_fence(__ATOMIC_RELEASE, "agent");
            asm volatile("s_waitcnt vmcnt(0)" ::: "memory");
            const unsigned og = xb_add(&bar[XB_TOP], 1u);
            const unsigned tg = og / nx;
            if (og + 1u == (tg + 1u) * nx) xb_add(&bar[XB_TOPGEN], 1u);
            else XB_SPIN(xb_ld(&bar[XB_TOPGEN]) == tg, bar);
            __builtin_amdgcn_fence(__ATOMIC_ACQUIRE, "agent");
            xb_add(&bar[XB_XGEN(b.x)], 1u);
            asm volatile("s_waitcnt vmcnt(0)" ::: "memory");
        } else {
            XB_SPIN(xb_ld(&bar[XB_XGEN(b.x)]) == gen, bar);
            __builtin_amdgcn_fence(__ATOMIC_ACQUIRE, "agent");
            asm volatile("s_waitcnt vmcnt(0)" ::: "memory");
        }
    }
    __syncthreads();
}

constexpr int XB_LDS_OFF = pg8::STAGE_BYTES + 8192 + 4096;
constexpr int LDS_BYTES = XB_LDS_OFF + 16;

__device__ __forceinline__ const Params* kparams() { int z = 0; asm volatile("" : "+s"(z)); z = __builtin_amdgcn_readfirstlane(z);
    return (const Params*)((const char*)__builtin_amdgcn_kernarg_segment_ptr() + z); }

__device__ __forceinline__ int opaque_count(int n) { asm volatile("" : "+s"(n)); return __builtin_amdgcn_readfirstlane(n); }

__global__ void __launch_bounds__(512, 2) fwd_megakernel(Params p_unused) {
    extern __shared__ __attribute__((aligned(16))) unsigned char lds_raw[];
    LAS unsigned char* lds = (LAS unsigned char*)lds_raw;
    cg::grid_group grid = cg::this_grid();
    { LAS unsigned* xbst = (LAS unsigned*)(lds + XB_LDS_OFF); if (threadIdx.x == 0) { xbst[0] = 0u; xbst[1] = 0u; } }
    __syncthreads();
    (void)xcd_barrier_post((unsigned*)(kparams()->ws + WS_BAR), (volatile LAS unsigned*)(lds + XB_LDS_OFF));
#define SEAM() do { XcdBarrier xb_; xb_.bar = (unsigned*)(kparams()->ws + WS_BAR); xb_.x = xb_xcc_id(); xb_.st = (volatile LAS unsigned*)(lds + XB_LDS_OFF); xcd_barrier(xb_); } while (0)
#define WSP(T, off) ((T*)(q->ws + (off)))
    constexpr int NOGRP = 30;
    const int G = gridDim.x;

#ifndef PROBE_PHASE
#define PROBE_PHASE -1
#endif
#define REPEAT(k) for (int rep_ = 0, n_ = opaque_count((k) == PROBE_PHASE ? 2 : 1); rep_ < n_; ++rep_)
#define XOUT() ((n_ == 2 && rep_ == 0) ? WSP(bf16_t, WS_END) : WSP(bf16_t, WS_X))
    if (threadIdx.x == 0) { unsigned* bw = (unsigned*)(kparams()->ws + WS_BAR); const unsigned xcc = xb_xcc_id(); const unsigned rank = xb_add(&bw[4 * xcc], 1u);
        ((LAS unsigned*)(lds + XB_LDS_OFF))[2] = rank * 8u + xcc; }
    if (opaque_count(0)) grid.sync();
    REPEAT(0) { phase0(*kparams(), lds); SEAM(); }
    int bid = blockIdx.x;
    { unsigned* bw = (unsigned*)(kparams()->ws + WS_BAR); bool ok = (gridDim.x == 256);
#pragma unroll
      for (int j = 0; j < 16; ++j) ok = ok && (xb_ld(&bw[4 * j]) == (j < 8 ? 32u : 0u));
      const int vc = (int)((LAS unsigned*)(lds + XB_LDS_OFF))[2];
      bid = __builtin_amdgcn_readfirstlane(ok ? vc : bid); }
    REPEAT(1) { phase1(*kparams(), lds); SEAM(); }
    REPEAT(2) {
        const Params* q = kparams();
        pg8::Gemm g{WSP(bf16_t, WS_H), WSP(bf16_t, WS_WPOOL), M, D, 512, D, 1, 8 * 16384}; pg8::StaticOrder S; S.init(M, D, G, bid);
        pg8::EpiRes<true> E{q->x, WSP(bf16_t, WS_X), WSP(float, WS_MOD) + 2 * D, q->pool_scale};
        pg8::gemm_phase(lds, g, S, E);
        SEAM();
    }
#pragma unroll
    for (int l = 0; l < 2; ++l) {
        if (l == 1) {
            REPEAT(7) { const Params* q = kparams(); const float* modl = WSP(float, WS_MOD) + (size_t)l * 2 * MODW;
              norm_phase<false>(WSP(bf16_t, WS_X), WSP(bf16_t, WS_H), q->n1g + D, modl + 0 * D, modl + 1 * D); SEAM(); }
            REPEAT(8) {
                const Params* q = kparams();
                pg8::Gemm g{WSP(bf16_t, WS_H), WSP(bf16_t, WS_WBCX), M, D, D, D, NOGRP, 0}; pg8::StaticOrder S; S.init(M, D, G, bid);
                pg8::EpiBf16 E{WSP(bf16_t, WS_ACT), D};
                pg8::gemm_phase(lds, g, S, E);
                SEAM();
            }
            REPEAT(9) {
                const Params* q = kparams();
                pg8::Gemm g{WSP(bf16_t, WS_H), WSP(bf16_t, WS_WBCX) + (size_t)D * D, M, 2 * D, D, D, NOGRP, 0}; pg8::StaticOrder S; S.init(M, 2 * D, G, bid);
                pg8::EpiConv<1> E{q->sconv_w, q->sconv_b, D, 0, WSP(bf16_t, WS_ACT) + (size_t)M * D, D, WSP(bf16_t, WS_ACT), WSP(float, WS_PART), WSP(float, WS_TAIL)};
                pg8::gemm_phase(lds, g, S, E);
                SEAM();
            }
            REPEAT(11) {
                const Params* q = kparams();
                pg8::Gemm g{WSP(bf16_t, WS_ACT) + (size_t)M * D, WSP(bf16_t, WS_WSOUT), M, D, D, D, NOGRP, 0}; pg8::StaticOrder S; S.init(M, D, G, bid);
                fixup_mine<1>(S, q->sconv_w, D, 0, D, WSP(float, WS_PART), WSP(float, WS_TAIL), WSP(bf16_t, WS_ACT) + (size_t)M * D, D, WSP(bf16_t, WS_ACT));
                pg8::EpiRes<false> E{WSP(bf16_t, WS_X), XOUT(), WSP(float, WS_MOD) + (size_t)l * 2 * MODW + 2 * D, nullptr};
                pg8::gemm_phase(lds, g, S, E);
                SEAM();
            }
        }
        REPEAT(l == 0 ? 3 : 12) { const Params* q = kparams(); const float* modl = WSP(float, WS_MOD) + (size_t)l * 2 * MODW;
          norm_phase<false>(WSP(bf16_t, WS_X), WSP(bf16_t, WS_H), q->n2g + l * D, modl + 3 * D, modl + 4 * D); SEAM(); }
        REPEAT(l == 0 ? 4 : 13) {
            const Params* q = kparams();
            pg8::Gemm g{WSP(bf16_t, WS_H), WSP(bf16_t, WS_WUP) + (size_t)l * NUP * D, M, NUP, D, D, NOGRP, 0}; pg8::StaticOrder S; S.init(M, NUP, G, bid);
            pg8::EpiConv<0> E{q->fconv_w + (size_t)l * 3 * NUP, q->fconv_b + (size_t)l * NUP, NUP, FF, WSP(bf16_t, WS_ACT), FF, nullptr, WSP(float, WS_PART), WSP(float, WS_TAIL)};
            pg8::gemm_phase(lds, g, S, E);
            SEAM();
        }
        REPEAT(l == 0 ? 6 : 15) {
            const Params* q = kparams();
            pg8::Gemm g{WSP(bf16_t, WS_ACT), WSP(bf16_t, WS_WDOWN) + (size_t)l * D * FF, M, D, FF, FF, NOGRP, 0}; pg8::StaticOrder S; S.init(M, D, G, bid);
            fixup_mine<0>(S, q->fconv_w + (size_t)l * 3 * NUP, NUP, FF, FF, WSP(float, WS_PART), WSP(float, WS_TAIL), WSP(bf16_t, WS_ACT), FF, nullptr);
            pg8::EpiRes<false> E{WSP(bf16_t, WS_X), XOUT(), WSP(float, WS_MOD) + (size_t)l * 2 * MODW + 5 * D, nullptr};
            pg8::gemm_phase(lds, g, S, E);
            SEAM();
        }
    }
    REPEAT(16) { const Params* q = kparams(); norm_phase<true>(WSP(bf16_t, WS_X), q->out, q->final_g, nullptr, nullptr); if (n_ == 2 && rep_ == 0) SEAM(); }
#undef REPEAT
#undef XOUT
#undef SEAM
#undef WSP
}

extern "C" void kernel_launch(void* const* d_in, const int* in_sizes, int n_in, void* d_out, int out_size, void* d_ws, size_t ws_size, hipStream_t stream) {
    static int grid_blocks = 0;
    if (grid_blocks == 0) {
        if (n_in != 17 || out_size != M * D || ws_size < WS_END) { fprintf(stderr, "kernel_launch: unexpected shapes (n_in %d out %d ws %zu need %zu)\n", n_in, out_size, ws_size, (size_t)WS_END); grid_blocks = -1; return; }
        int dev = 0, cus = 0, per_cu = 0;
        hipGetDevice(&dev);
        hipDeviceGetAttribute(&cus, hipDeviceAttributeMultiprocessorCount, dev);
        if (hipFuncSetAttribute((const void*)fwd_megakernel, hipFuncAttributeMaxDynamicSharedMemorySize, LDS_BYTES) != hipSuccess) { fprintf(stderr, "kernel_launch: hipFuncSetAttribute failed\n"); grid_blocks = -1; return; }
        if (hipOccupancyMaxActiveBlocksPerMultiprocessor(&per_cu, (const void*)fwd_megakernel, 512, LDS_BYTES) != hipSuccess || per_cu < 1) { fprintf(stderr, "kernel_launch: occupancy query says %d\n", per_cu); per_cu = 1; }
        (void)hipGetLastError();
        grid_blocks = cus;
    }
    if (grid_blocks < 0) return;
    if (hipMemsetAsync((char*)d_ws + WS_BAR, 0, 16384, stream) != hipSuccess) { fprintf(stderr, "kernel_launch: hipMemsetAsync failed\n"); return; }
    Params p{};
    const float** pp = (const float**)&p;
    for (int i = 0; i < 17; ++i) pp[i] = (const float*)d_in[i];
    p.out = (float*)d_out; p.ws = (unsigned char*)d_ws; p.ph_lo = 0; p.ph_hi = 0;
    void* args[] = {&p};
    hipError_t e = hipLaunchCooperativeKernel((const void*)fwd_megakernel, dim3(grid_blocks), dim3(512), args, LDS_BYTES, stream);
    if (e != hipSuccess) fprintf(stderr, "cooperative launch failed: %s (grid %d)\n", hipGetErrorString(e), grid_blocks);
}
```

```cpp
#include <hip/hip_runtime.h>
#include <hip/hip_cooperative_groups.h>
#include <cstdio>
namespace cg = cooperative_groups;

#define LAS __attribute__((address_space(3)))
typedef unsigned short bf16_t;
typedef short bf16x8 __attribute__((ext_vector_type(8)));
typedef float f32x4 __attribute__((ext_vector_type(4)));
typedef unsigned u32x4 __attribute__((ext_vector_type(4)));
typedef unsigned u32x2 __attribute__((ext_vector_type(2)));

constexpr int D = 2048, FF = 5632, NUP = 2 * FF, SEQ = 16384, NBATCH = 2, M = NBATCH * SEQ, MODW = 6 * D;
constexpr float EPS = 1e-6f;

constexpr size_t WS_WPOOL = 0;
constexpr size_t WS_WBCX  = WS_WPOOL + (size_t)2048 * 512 * 2;
constexpr size_t WS_WSOUT = WS_WBCX + (size_t)6144 * 2048 * 2;
constexpr size_t WS_WUP   = WS_WSOUT + (size_t)2048 * 2048 * 2;
constexpr size_t WS_WDOWN = WS_WUP + (size_t)2 * NUP * D * 2;
constexpr size_t WS_MOD   = WS_WDOWN + (size_t)2 * D * FF * 2;
constexpr size_t WS_H     = WS_MOD + (size_t)2 * 2 * MODW * 4;
constexpr size_t WS_ACT   = WS_H + (size_t)M * D * 2;
constexpr size_t WS_PART  = WS_ACT + (size_t)M * FF * 2;
constexpr size_t WS_TAIL  = WS_PART + (size_t)128 * 2 * NUP * 4;
constexpr size_t WS_X     = WS_TAIL + (size_t)128 * 2 * NUP * 4;
constexpr size_t WS_BAR   = WS_X + (size_t)M * D * 2;
constexpr size_t WS_END   = WS_BAR + 16384;

struct Params {
    const float *x, *c, *ada_w, *ada_b, *n1g, *n2g, *pool_w, *pool_scale, *bcx_w, *sconv_w, *sconv_b, *sout_w, *up_w, *fconv_w, *fconv_b, *down_w, *final_g;
    float* out; unsigned char* ws; int ph_lo, ph_hi;
};

__device__ __forceinline__ unsigned cvt_pk_bf16(float lo, float hi) { unsigned r; asm volatile("v_cvt_pk_bf16_f32 %0, %1, %2" : "=v"(r) : "v"(lo), "v"(hi)); return r; }

__device__ __forceinline__ size_t img_off(int row, int col, int K) {
    const int r = row & 127, c = col & 63;
    int ob = (r & 15) * 64 + (c & 31) * 2; ob ^= ((ob >> 9) & 1) << 5;
    const int b = ((r >> 4) * 2 + (c >> 5)) * 1024 + ob;
    return ((size_t)((row >> 7) * (K >> 6) + (col >> 6))) * 8192 + (size_t)(b >> 1);
}
__device__ __forceinline__ int invperm32(int c) { return 16 * ((c >> 2) & 1) + 4 * (c >> 3) + (c & 3); }

namespace pg8 {
constexpr int BM = 256, BK = 64, HALF = 128, HTB = HALF * BK * 2, STAGE_BYTES = 8 * HTB, NXCD = 8, WGM = 8;
__device__ __forceinline__ int lds_byte(int r, int c) { const int st = (r >> 4) * 2 + (c >> 5), rr = r & 15, cc = c & 31, ob = rr * 64 + cc * 2; return st * 1024 + (ob ^ (((ob >> 9) & 1) << 5)); }
__device__ __forceinline__ void stage_rc(int b, int& R, int& C) { const int st = b / 1024, sb = b % 1024, swz = sb ^ (((sb >> 9) & 1) << 5); R = (st >> 1) * 16 + swz / 64; C = (st & 1) * 32 + (swz % 64) / 2; }
__device__ __forceinline__ int perm32(int rho) { const int n = rho >> 4, i = rho & 15; return 8 * (i >> 2) + 4 * n + (i & 3); }

struct Unit { int pm, pn; };
struct Gemm { const bf16_t* A; const bf16_t* Bt; int M, N, K, lda, gshift, gstride; };

struct StaticOrder {
    int nM, nN, nwg, G, c;
    __device__ void init(int M_, int N_, int G_, int c_) { nM = M_ / BM; nN = N_ / BM; nwg = nM * nN; G = G_; c = c_; }
    __device__ bool next(int i, Unit& u) const {
        const long L = (long)i * G + c; if (L >= nwg) return false;
        int wgid = (int)L; { const int q = nwg / NXCD, r = nwg % NXCD, xcd = wgid % NXCD, off = wgid / NXCD; wgid = (xcd < r ? xcd * (q + 1) : r * (q + 1) + (xcd - r) * q) + off; }
        const int nig = WGM * nN, gid = wgid / nig, fm = gid * WGM, gsz = (nM - fm) < WGM ? (nM - fm) : WGM;
        u.pm = fm + ((wgid % nig) % gsz); u.pn = (wgid % nig) / gsz; return true;
    }
};

template <class Epi>
__device__ __forceinline__ void gemm_phase(LAS unsigned char* lds, const Gemm g, const StaticOrder& S, const Epi& E) {
    int tid = threadIdx.x; asm volatile("" : "+v"(tid));
    const int wid = __builtin_amdgcn_readfirstlane(tid >> 6), lane = tid & 63, wr = wid >> 2, wc = wid & 3, fr = lane & 15, fq = lane >> 4;
    const int K = g.K, nt = K / BK;
    const unsigned voff0 = (unsigned)(tid * 16);
    const unsigned hA = (unsigned)(g.lda * 256), hB = (unsigned)(K * 256);
    constexpr int KS = 16384;
    const size_t tstepA = (size_t)BM * g.lda * 2, tstepB = (size_t)BM * K * 2;
    const unsigned lds0 = (unsigned)__builtin_amdgcn_readfirstlane((int)((unsigned)(size_t)lds + (unsigned)wid * 1024u));
    const int aoff = lds_byte(wr * 64 + fr, fq * 8), boff = lds_byte(wc * 32 + fr, fq * 8);
#define PG8_SA(b, h) (((b) * 2 + (h)) * HTB)
#define PG8_SB(b, h) ((4 + (b) * 2 + (h)) * HTB)
#define PG8_STAGE(bufoff, gbase, hoff, imm) do { _Pragma("unroll") for (int _i = 0; _i < 2; ++_i) { unsigned _keep; \
        asm volatile("s_mov_b32 %0, m0\n\ts_mov_b32 m0, %1\n\ts_nop 0\n\tglobal_load_lds_dwordx4 %2, %3\n\ts_mov_b32 m0, %0" \
            : "=&s"(_keep) : "s"(lds0 + (unsigned)((bufoff) + _i * 8192)), "v"(voff0), "s"((const char*)(gbase) + (size_t)(hoff) + (size_t)(_i * 8192)) : "memory"); } } while (0)
#define PG8_LDA(dst, b, h) do { _Pragma("unroll") for (int m = 0; m < 4; ++m) _Pragma("unroll") for (int k = 0; k < 2; ++k) dst[m][k] = *(const LAS bf16x8*)(lds + PG8_SA(b, h) + aoff + m * 2048 + k * 1024); } while (0)
#define PG8_LDB(dst, b, h) do { _Pragma("unroll") for (int n = 0; n < 2; ++n) _Pragma("unroll") for (int k = 0; k < 2; ++k) dst[n][k] = *(const LAS bf16x8*)(lds + PG8_SB(b, h) + boff + n * 2048 + k * 1024); } while (0)
#define PG8_MMA(ai, bj, At, Bt) do { __builtin_amdgcn_s_setprio(1); _Pragma("unroll") for (int m = 0; m < 4; ++m) _Pragma("unroll") for (int n = 0; n < 2; ++n) _Pragma("unroll") for (int k = 0; k < 2; ++k) \
        acc[ai][bj][m][n] = __builtin_amdgcn_mfma_f32_16x16x32_bf16(Bt[n][k], At[m][k], acc[ai][bj][m][n], 0, 0, 0); __builtin_amdgcn_s_setprio(0); } while (0)
#define PG8_WAIT_V(n) asm volatile("s_waitcnt vmcnt(" #n ")" ::: "memory")
#define PG8_WAIT_L(n) asm volatile("s_waitcnt lgkmcnt(" #n ")" ::: "memory")
#define PG8_BAR __builtin_amdgcn_s_barrier()
#define PG8_SCHED __builtin_amdgcn_sched_barrier(0)
    Unit cur, nxt; int ui = 0;
    if (!S.next(0, cur)) return;
    f32x4 acc[2][2][4][2];
#pragma unroll
    for (int a = 0; a < 2; ++a)
#pragma unroll
        for (int b = 0; b < 2; ++b)
#pragma unroll
            for (int m = 0; m < 4; ++m)
#pragma unroll
                for (int n = 0; n < 2; ++n) acc[a][b][m][n] = (f32x4){0.f, 0.f, 0.f, 0.f};
    bf16x8 At[4][2], B0[2][2], B1[2][2];
    const char* cA = (const char*)g.A + (size_t)cur.pm * tstepA + (size_t)(cur.pn >> g.gshift) * g.gstride; const char* cB = (const char*)g.Bt + (size_t)cur.pn * tstepB;
    PG8_STAGE(PG8_SB(0, 0), cB, 0, 0); PG8_STAGE(PG8_SA(0, 0), cA, 0, 0); PG8_STAGE(PG8_SB(0, 1), cB, hB, 0); PG8_STAGE(PG8_SA(0, 1), cA, hA, 0);
    if (wr == 1) PG8_BAR;
    PG8_WAIT_V(4); PG8_BAR;
    PG8_STAGE(PG8_SB(1, 0), cB + KS, 0, 0); PG8_STAGE(PG8_SA(1, 0), cA + KS, 0, 0); PG8_STAGE(PG8_SB(1, 1), cB + KS, hB, 0);
    PG8_WAIT_V(6); PG8_BAR;
    for (;;) {
        const bool has_next = S.next(ui + 1, nxt);
        const char* nA = has_next ? (const char*)g.A + (size_t)nxt.pm * tstepA + (size_t)(nxt.pn >> g.gshift) * g.gstride : cA;
        const char* nB = has_next ? (const char*)g.Bt + (size_t)nxt.pn * tstepB : cB;
        for (int t = 0; t < nt; t += 2) {
            const bool last = (t == nt - 2);
            if (last) E.pre(cur, wid, lane, (unsigned)(size_t)(lds + STAGE_BYTES));
            const char* aT = cA + (size_t)t * KS;
            const char* a2 = last ? nA : aT + 2 * KS; const char* b2 = last ? nB : cB + (size_t)(t + 2) * KS;
            PG8_LDB(B0, 0, 0); PG8_SCHED; PG8_LDA(At, 0, 0); PG8_STAGE(PG8_SA(1, 1), aT + KS, hA, 0);
            PG8_WAIT_L(8); PG8_BAR; PG8_WAIT_L(0); PG8_MMA(0, 0, At, B0); PG8_BAR; PG8_SCHED;
            PG8_LDB(B1, 0, 1); PG8_STAGE(PG8_SB(0, 0), b2, 0, 0);
            PG8_BAR; PG8_WAIT_L(0); PG8_MMA(0, 1, At, B1); PG8_BAR;
            PG8_LDA(At, 0, 1); PG8_STAGE(PG8_SA(0, 0), a2, 0, 0);
            PG8_BAR; PG8_WAIT_L(0); PG8_MMA(1, 0, At, B0); PG8_BAR; PG8_SCHED;
            PG8_STAGE(PG8_SB(0, 1), b2, hB, 0);
            PG8_WAIT_V(6); PG8_BAR; PG8_MMA(1, 1, At, B1); PG8_BAR;
            PG8_LDB(B0, 1, 0); PG8_SCHED; PG8_LDA(At, 1, 0); PG8_STAGE(PG8_SA(0, 1), a2, hA, 0);
            PG8_WAIT_L(8); PG8_BAR; PG8_WAIT_L(0); PG8_MMA(0, 0, At, B0); PG8_BAR; PG8_SCHED;
            PG8_LDB(B1, 1, 1); PG8_STAGE(PG8_SB(1, 0), b2 + KS, 0, 0);
            PG8_BAR; PG8_WAIT_L(0); PG8_MMA(0, 1, At, B1); PG8_BAR;
            PG8_LDA(At, 1, 1); PG8_STAGE(PG8_SA(1, 0), a2 + KS, 0, 0);
            PG8_BAR; PG8_WAIT_L(0); PG8_MMA(1, 0, At, B0); PG8_BAR; PG8_SCHED;
            PG8_STAGE(PG8_SB(1, 1), b2 + KS, hB, 0);
            PG8_WAIT_V(6); PG8_BAR; PG8_MMA(1, 1, At, B1); PG8_BAR;
        }
        E(acc, cur, wr, wc, fr, fq, lds + STAGE_BYTES);
        if (!has_next) break;
#pragma unroll
        for (int a = 0; a < 2; ++a)
#pragma unroll
            for (int b = 0; b < 2; ++b)
#pragma unroll
                for (int m = 0; m < 4; ++m)
#pragma unroll
                    for (int n = 0; n < 2; ++n) acc[a][b][m][n] = (f32x4){0.f, 0.f, 0.f, 0.f};
        cur = nxt; cA = nA; cB = nB; ++ui;
    }
    PG8_WAIT_V(0);
    if (wr == 0) PG8_BAR;
    PG8_BAR;
#undef PG8_SA
#undef PG8_SB
#undef PG8_STAGE
#undef PG8_LDA
#undef PG8_LDB
#undef PG8_MMA
#undef PG8_WAIT_V
#undef PG8_WAIT_L
#undef PG8_SCHED
}

template <bool IN_F32> struct EpiRes {
    static constexpr bool PERM = true;
    const void* in; bf16_t* out; const float* gate; const float* cs;
    __device__ __forceinline__ void pre(const Unit&, int, int, unsigned) const {}
    __device__ __forceinline__ void operator()(f32x4 (&acc)[2][2][4][2], const Unit& u, int wr, int wc, int fr, int fq, LAS unsigned char*) const {
        const int b = u.pm >> 6;
        const int col0 = u.pn * BM + wc * 32 + 8 * fq;
        const size_t off0 = (size_t)(u.pm * BM + wr * 64 + fr) * D + col0;
        f32x4 sc[2][2];
#pragma unroll
        for (int bj = 0; bj < 2; ++bj)
#pragma unroll
            for (int n = 0; n < 2; ++n) { f32x4 gt = *(const f32x4*)(gate + (size_t)b * MODW + col0 + bj * HALF + n * 4); sc[bj][n] = gt + 1.0f;
                if (cs) sc[bj][n] *= *(const f32x4*)(cs + col0 + bj * HALF + n * 4); }
        if (IN_F32) {
#pragma unroll
            for (int ai = 0; ai < 2; ++ai) {
                f32x4 r[4][2][2];
#pragma unroll
                for (int m = 0; m < 4; ++m)
#pragma unroll
                    for (int bj = 0; bj < 2; ++bj)
#pragma unroll
                        for (int n = 0; n < 2; ++n) r[m][bj][n] = *(const f32x4*)((const float*)in + off0 + (size_t)(ai * HALF + m * 16) * D + bj * HALF + n * 4);
#pragma unroll
                for (int m = 0; m < 4; ++m)
#pragma unroll
                    for (int bj = 0; bj < 2; ++bj) { const f32x4 r0 = r[m][bj][0] + sc[bj][0] * acc[ai][bj][m][0], r1 = r[m][bj][1] + sc[bj][1] * acc[ai][bj][m][1];
                        u32x4 w; w.x = cvt_pk_bf16(r0[0], r0[1]); w.y = cvt_pk_bf16(r0[2], r0[3]); w.z = cvt_pk_bf16(r1[0], r1[1]); w.w = cvt_pk_bf16(r1[2], r1[3]);
                        *(u32x4*)(out + off0 + (size_t)(ai * HALF + m * 16) * D + bj * HALF) = w; }
                asm volatile("" ::: "memory");
            }
        } else {
            u32x4 xb[2][4][2];
#pragma unroll
            for (int ai = 0; ai < 2; ++ai)
#pragma unroll
                for (int m = 0; m < 4; ++m)
#pragma unroll
                    for (int bj = 0; bj < 2; ++bj) xb[ai][m][bj] = *(const u32x4*)((const bf16_t*)in + off0 + (size_t)(ai * HALF + m * 16) * D + bj * HALF);
#pragma unroll
            for (int ai = 0; ai < 2; ++ai)
#pragma unroll
                for (int m = 0; m < 4; ++m)
#pragma unroll
                    for (int bj = 0; bj < 2; ++bj) { const u32x4 x = xb[ai][m][bj];
                        f32x4 r0 = (f32x4){__uint_as_float(x.x << 16), __uint_as_float(x.x & 0xffff0000u), __uint_as_float(x.y << 16), __uint_as_float(x.y & 0xffff0000u)};
                        f32x4 r1 = (f32x4){__uint_as_float(x.z << 16), __uint_as_float(x.z & 0xffff0000u), __uint_as_float(x.w << 16), __uint_as_float(x.w & 0xffff0000u)};
                        r0 += sc[bj][0] * acc[ai][bj][m][0]; r1 += sc[bj][1] * acc[ai][bj][m][1];
                        u32x4 w; w.x = cvt_pk_bf16(r0[0], r0[1]); w.y = cvt_pk_bf16(r0[2], r0[3]); w.z = cvt_pk_bf16(r1[0], r1[1]); w.w = cvt_pk_bf16(r1[2], r1[3]);
                        *(u32x4*)(out + off0 + (size_t)(ai * HALF + m * 16) * D + bj * HALF) = w; }
        }
    }
};
struct EpiBf16 {
    static constexpr bool PERM = true;
    bf16_t* O; int ldc;
    __device__ __forceinline__ void pre(const Unit&, int, int, unsigned) const {}
    __device__ __forceinline__ void operator()(f32x4 (&acc)[2][2][4][2], const Unit& u, int wr, int wc, int fr, int fq, LAS unsigned char*) const {
        const int row0 = u.pm * BM + wr * 64 + fr, col0 = u.pn * BM + wc * 32 + 8 * fq;
#pragma unroll
        for (int ai = 0; ai < 2; ++ai)
#pragma unroll
            for (int m = 0; m < 4; ++m) { bf16_t* rowp = O + (size_t)(row0 + ai * HALF + m * 16) * ldc + col0;
#pragma unroll
                for (int bj = 0; bj < 2; ++bj) { const f32x4 v0 = acc[ai][bj][m][0], v1 = acc[ai][bj][m][1];
                    u32x4 w; w.x = cvt_pk_bf16(v0[0], v0[1]); w.y = cvt_pk_bf16(v0[2], v0[3]); w.z = cvt_pk_bf16(v1[0], v1[1]); w.w = cvt_pk_bf16(v1[2], v1[3]);
                    *(u32x4*)(rowp + bj * HALF) = w; } }
    }
};

__device__ __forceinline__ float dpp_ror1(float s) { return __int_as_float(__builtin_amdgcn_update_dpp(0, __float_as_int(s), 0x121, 0xf, 0xf, false)); }
__device__ __forceinline__ float dpp_ror2(float s) { return __int_as_float(__builtin_amdgcn_update_dpp(0, __float_as_int(s), 0x122, 0xf, 0xf, false)); }
__device__ __forceinline__ float dpp_shr1(float old, float s) { return __int_as_float(__builtin_amdgcn_update_dpp(__float_as_int(old), __float_as_int(s), 0x111, 0xf, 0xf, false)); }
__device__ __forceinline__ float dpp_shr2(float old, float s) { return __int_as_float(__builtin_amdgcn_update_dpp(__float_as_int(old), __float_as_int(s), 0x112, 0xf, 0xf, false)); }
__device__ __forceinline__ float conv1(float cur, float prv, float w0, float w1, float w2, float b) {
    float r, t1, t2;
    asm volatile(
        "s_nop 1\n\t"
        "v_mov_b32_dpp %1, %4 row_ror:1 row_mask:0xf bank_mask:0xf\n\t"
        "v_mov_b32_dpp %2, %4 row_ror:2 row_mask:0xf bank_mask:0xf\n\t"
        "v_fma_f32 %0, %7, %3, %8\n\t"
        "v_mov_b32_dpp %1, %3 row_shr:1 row_mask:0xf bank_mask:0xf\n\t"
        "v_mov_b32_dpp %2, %3 row_shr:2 row_mask:0xf bank_mask:0xf\n\t"
        "v_fmac_f32 %0, %6, %1\n\t"
        "v_fmac_f32 %0, %5, %2\n\t"
        : "=&v"(r), "=&v"(t1), "=&v"(t2) : "v"(cur), "v"(prv), "v"(w0), "v"(w1), "v"(w2), "v"(b));
    return r;
}
__device__ __forceinline__ f32x4 conv3(const f32x4 cur, const f32x4 prv, const f32x4 w0, const f32x4 w1, const f32x4 w2, const f32x4 bb) {
    f32x4 r;
#pragma unroll
    for (int j = 0; j < 4; ++j) r[j] = conv1(cur[j], prv[j], w0[j], w1[j], w2[j], bb[j]);
    return r;
}
__device__ __forceinline__ float silu_f(float g) { return g * __builtin_amdgcn_rcpf(1.0f + __builtin_amdgcn_exp2f(-1.44269504089f * g)); }

template <int MODE> struct EpiConv {
    static constexpr bool PERM = true;
    const float* cw; const float* cb; int C; int voff;
    bf16_t* O; int ldo; const bf16_t* BG; float* PART; float* TAIL;
    __device__ __forceinline__ void pre(const Unit& u, int wid, int lane, unsigned ldsx) const {
        if (wid < 4) {
            const int c = lane * 4, s = c >> 7;
            const unsigned vo = (unsigned)(((MODE == 0 && s) ? voff : 0) + (c & 127)) * 4u;
            const char* base = (const char*)((wid < 3 ? cw + (size_t)wid * C : cb) + 128 * u.pn);
            unsigned keep;
            asm volatile("s_mov_b32 %0, m0\n\ts_mov_b32 m0, %1\n\ts_nop 0\n\tglobal_load_lds_dwordx4 %2, %3\n\ts_mov_b32 m0, %0"
                : "=&s"(keep) : "s"(ldsx + 8192u + (unsigned)wid * 1024u), "v"(vo), "s"(base) : "memory");
        }
    }
    __device__ __forceinline__ void operator()(f32x4 (&acc)[2][2][4][2], const Unit& u, int wr, int wc, int fr, int fq, LAS unsigned char* xl) const {
        constexpr int NS = MODE == 0 ? 2 : 1;
        const int chl = 32 * wc + 8 * fq, ch0 = 128 * u.pn + chl;
        LAS float* bnd = (LAS float*)xl;
        LAS float* wt = (LAS float*)(xl + 8192);
        asm volatile("s_waitcnt vmcnt(16)" ::: "memory");
        if (MODE == 1) {
#pragma unroll
            for (int ai = 0; ai < 2; ++ai)
#pragma unroll
                for (int m = 0; m < 4; ++m)
#pragma unroll
                    for (int n = 0; n < 2; ++n) acc[ai][0][m][n] *= acc[ai][1][m][n];
        }
        if (fr >= 14) {
#pragma unroll
            for (int ai = 0; ai < 2; ++ai)
#pragma unroll
                for (int s = 0; s < NS; ++s)
#pragma unroll
                    for (int n = 0; n < 2; ++n) *(LAS f32x4*)(bnd + (((ai * 2 + wr) * 2 + (fr - 14)) * 256 + s * 128 + chl + 4 * n)) = acc[ai][s][3][n];
            if (wr == 1) {
#pragma unroll
                for (int s = 0; s < NS; ++s)
#pragma unroll
                    for (int n = 0; n < 2; ++n) *(f32x4*)(TAIL + (size_t)(u.pm * 2 + (fr - 14)) * C + (s ? voff : 0) + ch0 + 4 * n) = acc[1][s][3][n];
            }
        }
        asm volatile("s_waitcnt lgkmcnt(0)" ::: "memory"); PG8_BAR; asm volatile("" ::: "memory"); PG8_BAR; asm volatile("" ::: "memory");
        u32x4 bgv[2][4];
        if (MODE == 1) {
#pragma unroll
            for (int ai = 0; ai < 2; ++ai)
#pragma unroll
                for (int m = 0; m < 4; ++m) bgv[ai][m] = *(const u32x4*)(BG + (size_t)(u.pm * BM + ai * HALF + wr * 64 + m * 16 + fr) * D + ch0);
        }
#pragma unroll
        for (int s = 0; s < NS; ++s)
#pragma unroll
            for (int n = 0; n < 2; ++n) {
                const int lc = s * 128 + chl + 4 * n;
                const f32x4 w0 = *(const LAS f32x4*)(wt + lc), w1 = *(const LAS f32x4*)(wt + 256 + lc), w2 = *(const LAS f32x4*)(wt + 512 + lc), bb = *(const LAS f32x4*)(wt + 768 + lc);
#pragma unroll
                for (int ai = 0; ai < 2; ++ai) {
                    const int blk = ai * 2 + wr;
                    f32x4 pg = (f32x4){0.f, 0.f, 0.f, 0.f};
                    if (blk > 0) pg = *(const LAS f32x4*)(bnd + (((blk - 1) * 2 + (fr & 1)) * 256 + lc));
#pragma unroll
                    for (int m = 3; m >= 0; --m) acc[ai][s][m][n] = conv3(acc[ai][s][m][n], m == 0 ? pg : acc[ai][s][m - 1][n], w0, w1, w2, bb);
                }
                __builtin_amdgcn_sched_barrier(0);
            }
        if (wr == 0 && fr < 2) {
#pragma unroll
            for (int s = 0; s < NS; ++s)
#pragma unroll
                for (int n = 0; n < 2; ++n) *(f32x4*)(PART + (size_t)(u.pm * 2 + fr) * C + (s ? voff : 0) + ch0 + 4 * n) = acc[0][s][0][n];
        }
#pragma unroll
        for (int ai = 0; ai < 2; ++ai)
#pragma unroll
            for (int m = 0; m < 4; ++m) {
                const size_t row = (size_t)(u.pm * BM + ai * HALF + wr * 64 + m * 16 + fr);
                f32x4 o0, o1;
                if (MODE == 0) {
#pragma unroll
                    for (int j = 0; j < 4; ++j) { o0[j] = silu_f(acc[ai][0][m][0][j]) * acc[ai][1][m][0][j]; o1[j] = silu_f(acc[ai][0][m][1][j]) * acc[ai][1][m][1][j]; }
                } else {
                    const u32x4 bg = bgv[ai][m];
                    o0[0] = __uint_as_float(bg.x << 16) * acc[ai][0][m][0][0]; o0[1] = __uint_as_float(bg.x & 0xffff0000u) * acc[ai][0][m][0][1];
                    o0[2] = __uint_as_float(bg.y << 16) * acc[ai][0][m][0][2]; o0[3] = __uint_as_float(bg.y & 0xffff0000u) * acc[ai][0][m][0][3];
                    o1[0] = __uint_as_float(bg.z << 16) * acc[ai][0][m][1][0]; o1[1] = __uint_as_float(bg.z & 0xffff0000u) * acc[ai][0][m][1][1];
                    o1[2] = __uint_as_float(bg.w << 16) * acc[ai][0][m][1][2]; o1[3] = __uint_as_float(bg.w & 0xffff0000u) * acc[ai][0][m][1][3];
                }
                u32x4 w; w.x = cvt_pk_bf16(o0[0], o0[1]); w.y = cvt_pk_bf16(o0[2], o0[3]); w.z = cvt_pk_bf16(o1[0], o1[1]); w.w = cvt_pk_bf16(o1[2], o1[3]);
                __builtin_nontemporal_store(w, (u32x4*)(O + img_off((int)row, ch0, ldo)));
                if (m & 1) __builtin_amdgcn_sched_barrier(0);
            }
    }
};
#undef PG8_BAR
}

__device__ __forceinline__ float wave_sum(float v) {
#pragma unroll
    for (int o = 32; o >= 1; o >>= 1) v += __shfl_xor(v, o);
    return v;
}

__device__ void p0_gemv(const Params& p, int item, LAS float* lds) {
    const int tid = threadIdx.x;
    const int l = item / 192, n0 = (item % 192) * 64;
    LAS float* cs = lds; LAS float* red = lds + 4096;
    for (int i = tid; i < 4096; i += 512) cs[i] = p.c[i];
    __syncthreads();
    const int l4 = tid & 15, kg = tid >> 4;
    const float* w = p.ada_w + (size_t)l * D * MODW + n0 + l4 * 4;
    f32x4 a0 = (f32x4){0.f, 0.f, 0.f, 0.f}, a1 = a0;
#pragma unroll 8
    for (int kk = 0; kk < 64; ++kk) { const int k = kg * 64 + kk; const f32x4 wv = *(const f32x4*)(w + (size_t)k * MODW); a0 += wv * cs[k]; a1 += wv * cs[2048 + k]; }
    *(LAS f32x4*)(red + (kg * 2 + 0) * 64 + l4 * 4) = a0; *(LAS f32x4*)(red + (kg * 2 + 1) * 64 + l4 * 4) = a1;
    __syncthreads();
    if (tid < 128) { const int b = tid >> 6, n = tid & 63; float s = 0.f;
        for (int g = 0; g < 32; ++g) s += red[(g * 2 + b) * 64 + n];
        s += p.ada_b[l * MODW + n0 + n];
        ((float*)(p.ws + WS_MOD))[(size_t)(l * 2 + b) * MODW + n0 + n] = s; }
    __syncthreads();
}
__device__ void tconv_tile(const float* src, int lds_, int k0, int n0, bf16_t* dst, int ldd, int drow0, bool perm, LAS float* t) {
    const int tid = threadIdx.x;
#pragma unroll
    for (int i = 0; i < 2; ++i) { const int idx = tid + i * 512, r = idx >> 4, c4 = idx & 15;
        const f32x4 v = *(const f32x4*)(src + (size_t)(k0 + r) * lds_ + n0 + c4 * 4);
        LAS float* q = t + r * 65 + c4 * 4; q[0] = v[0]; q[1] = v[1]; q[2] = v[2]; q[3] = v[3]; }
    __syncthreads();
    const int n = tid >> 3, kc = tid & 7;
    float f[8];
#pragma unroll
    for (int i = 0; i < 8; ++i) f[i] = t[(kc * 8 + i) * 65 + n];
    u32x4 w; w.x = cvt_pk_bf16(f[0], f[1]); w.y = cvt_pk_bf16(f[2], f[3]); w.z = cvt_pk_bf16(f[4], f[5]); w.w = cvt_pk_bf16(f[6], f[7]);
    { const int R = drow0 + n, Rs = perm ? ((R & ~31) + invperm32(R & 31)) : R; *(u32x4*)(dst + img_off(Rs, k0 + kc * 8, ldd)) = w; }
    __syncthreads();
}
__device__ __forceinline__ int unit_row(int ch, int second) { return 256 * (ch >> 7) + (second ? 128 : 0) + (ch & 127); }
__device__ void phase0(const Params& p, LAS unsigned char* lds) {
    LAS float* fl = (LAS float*)lds;
    constexpr int N_GEMV = 384, T_POOL = 256, T_BCX = 3072, T_SOUT = 1024, T_UP = 5632, T_DOWN = 2816;
    constexpr int TOTAL = N_GEMV + T_POOL + T_BCX + T_SOUT + 2 * T_UP + 2 * T_DOWN;
    for (int it = blockIdx.x; it < TOTAL; it += gridDim.x) {
        int i = it;
        if (i < N_GEMV) { p0_gemv(p, i, fl); continue; }
        i -= N_GEMV;
        if (i < T_POOL) { const int g = i >> 6, rem = i & 63, kt = rem >> 3, nt = rem & 7;
            tconv_tile(p.pool_w + (size_t)g * 512 * 512, 512, kt * 64, nt * 64, (bf16_t*)(p.ws + WS_WPOOL), 512, g * 512 + nt * 64, true, fl); continue; }
        i -= T_POOL;
        if (i < T_BCX) { const int kt = i / 96, nt = i % 96, n0 = nt * 64;
            const int drow0 = n0 < 2048 ? n0 : (n0 < 4096 ? 2048 + unit_row(n0 - 2048, 0) : 2048 + unit_row(n0 - 4096, 1));
            tconv_tile(p.bcx_w, 3 * D, kt * 64, n0, (bf16_t*)(p.ws + WS_WBCX), D, drow0, true, fl); continue; }
        i -= T_BCX;
        if (i < T_SOUT) { const int kt = i >> 5, nt = i & 31;
            tconv_tile(p.sout_w, D, kt * 64, nt * 64, (bf16_t*)(p.ws + WS_WSOUT), D, nt * 64, true, fl); continue; }
        i -= T_SOUT;
        if (i < 2 * T_UP) { const int l = i / T_UP, j = i % T_UP, kt = j / 176, nt = j % 176, n0 = nt * 64;
            const int drow0 = n0 < FF ? unit_row(n0, 0) : unit_row(n0 - FF, 1);
            tconv_tile(p.up_w + (size_t)l * D * NUP, NUP, kt * 64, n0, (bf16_t*)(p.ws + WS_WUP) + (size_t)l * NUP * D, D, drow0, true, fl); continue; }
        i -= 2 * T_UP;
        { const int l = i / T_DOWN, j = i % T_DOWN, kt = j >> 5, nt = j & 31;
            tconv_tile(p.down_w + (size_t)l * FF * D, D, kt * 64, nt * 64, (bf16_t*)(p.ws + WS_WDOWN) + (size_t)l * D * FF, FF, nt * 64, true, fl); }
    }
}

template <int W>
__device__ __forceinline__ void pool_chunk(const float* x, bf16_t* P, const LAS float* rs  , const f32x4 gs, const f32x4 sh, size_t r0, bool has_halo, int tid) {
    f32x4 ring[W];
#pragma unroll
    for (int j = 0; j < W; ++j) ring[j] = (f32x4){0.f, 0.f, 0.f, 0.f};
    f32x4 s = (f32x4){0.f, 0.f, 0.f, 0.f};
    const float* xp = x + r0 * D + tid * 4;
    if (has_halo) {
#pragma unroll
        for (int j = 0; j < W - 1; ++j) { const int t = -(W - 1) + j; const f32x4 h = *(const f32x4*)(xp + (long)t * D) * rs[t + 15] * gs + sh; ring[j] = h; s += h; }
    }
    for (int i0 = 0; i0 < 128; i0 += 16) {
        f32x4 xv[16];
#pragma unroll
        for (int jj = 0; jj < 16; ++jj) xv[jj] = *(const f32x4*)(xp + (size_t)(i0 + jj) * D);
#pragma unroll
        for (int jj = 0; jj < 16; ++jj) { const int i = i0 + jj; constexpr int dummy = 0; (void)dummy;
            const int slot = (W - 1 + jj) % W;
            const f32x4 h = xv[jj] * rs[i + 15] * gs + sh;
            s += h - ring[slot]; ring[slot] = h;
            const float inv = has_halo ? (1.0f / W) : (1.0f / (float)((i + 1) < W ? (i + 1) : W));
            const f32x4 o = s * inv - h;
            u32x2 w; w.x = cvt_pk_bf16(o[0], o[1]); w.y = cvt_pk_bf16(o[2], o[3]);
            *(u32x2*)(P + img_off((int)(r0 + i), tid * 4, D)) = w; }
    }
}
__device__ void phase1(const Params& p, LAS unsigned char* lds) {
    LAS float* rs = (LAS float*)lds;
    const int tid = threadIdx.x, wave = tid >> 6, lane = tid & 63;
    const float* mod = (const float*)(p.ws + WS_MOD);
    bf16_t* P = (bf16_t*)(p.ws + WS_H);
    for (int it = blockIdx.x; it < M / 128; it += gridDim.x) {
        const size_t r0 = (size_t)it * 128; const int b = (int)(r0 / SEQ); const bool has_halo = (r0 % SEQ) != 0;
        for (int t = (has_halo ? -15 : 0) + wave; t < 128; t += 8) {
            const float* xr = p.x + (r0 + t) * D + lane * 4; float ss = 0.f;
#pragma unroll
            for (int i = 0; i < 8; ++i) { const f32x4 v = *(const f32x4*)(xr + i * 256); ss += v[0] * v[0] + v[1] * v[1] + v[2] * v[2] + v[3] * v[3]; }
            ss = wave_sum(ss);
            if (lane == 0) rs[t + 15] = 1.0f / sqrtf(ss * (1.0f / D) + EPS);
        }
        __syncthreads();
        const f32x4 g4 = *(const f32x4*)(p.n1g + tid * 4);
        const f32x4 sc = *(const f32x4*)(mod + (size_t)b * MODW + 1 * D + tid * 4), sh = *(const f32x4*)(mod + (size_t)b * MODW + 0 * D + tid * 4);
        const f32x4 gs = g4 * (sc + 1.0f);
        const int grp = tid >> 7;
        if (grp == 0) pool_chunk<2>(p.x, P, rs, gs, sh, r0, has_halo, tid);
        else if (grp == 1) pool_chunk<4>(p.x, P, rs, gs, sh, r0, has_halo, tid);
        else if (grp == 2) pool_chunk<8>(p.x, P, rs, gs, sh, r0, has_halo, tid);
        else pool_chunk<16>(p.x, P, rs, gs, sh, r0, has_halo, tid);
        __syncthreads();
    }
}

template <bool FINAL>
__device__ void norm_phase(const bf16_t* X, void* dst, const float* gvec, const float* mod_sh, const float* mod_sc) {
    int tid = threadIdx.x; asm volatile("" : "+v"(tid));
    const int wave = tid >> 6, lane = tid & 63;
    for (int c = blockIdx.x * 8 + wave; c < M / 16; c += gridDim.x * 8) {
        const size_t row0 = (size_t)c * 16; const int b = (int)(row0 / SEQ);
        f32x4 gs[8], sh[8];
#pragma unroll
        for (int i = 0; i < 8; ++i) { const int col = i * 256 + lane * 4; gs[i] = *(const f32x4*)(gvec + col);
            if (!FINAL) { gs[i] *= (*(const f32x4*)(mod_sc + (size_t)b * MODW + col) + 1.0f); sh[i] = *(const f32x4*)(mod_sh + (size_t)b * MODW + col); } }
        for (int r = 0; r < 16; r += 2) {
            u32x2 xb[2][8];
#pragma unroll
            for (int h = 0; h < 2; ++h)
#pragma unroll
                for (int i = 0; i < 8; ++i) xb[h][i] = *(const u32x2*)(X + (row0 + r + h) * D + lane * 4 + i * 256);
#pragma unroll
            for (int h = 0; h < 2; ++h) {
                f32x4 v[8]; float ss = 0.f;
#pragma unroll
                for (int i = 0; i < 8; ++i) { const u32x2 x = xb[h][i];
                    v[i] = (f32x4){__uint_as_float(x.x << 16), __uint_as_float(x.x & 0xffff0000u), __uint_as_float(x.y << 16), __uint_as_float(x.y & 0xffff0000u)};
                    ss += v[i][0] * v[i][0] + v[i][1] * v[i][1] + v[i][2] * v[i][2] + v[i][3] * v[i][3]; }
                ss = wave_sum(ss);
                const float rstd = 1.0f / sqrtf(ss * (1.0f / D) + EPS);
#pragma unroll
                for (int i = 0; i < 8; ++i) { const int col = i * 256 + lane * 4;
                    if (FINAL) { __builtin_nontemporal_store(v[i] * rstd * gs[i], (f32x4*)((float*)dst + (row0 + r + h) * D + col)); }
                    else { const f32x4 hh = v[i] * rstd * gs[i] + sh[i]; u32x2 w; w.x = cvt_pk_bf16(hh[0], hh[1]); w.y = cvt_pk_bf16(hh[2], hh[3]);
                        *(u32x2*)((bf16_t*)dst + img_off((int)(row0 + r + h), col, D)) = w; } }
            }
        }
    }
}

template <int MODE>
__device__ void fixup_tile(int pm, const float* cw, int C, int voff, int nch, const float* PART, const float* TAIL, bf16_t* O, int ldo, const bf16_t* BG) {
    const int nq = nch / 4;
    int tid = threadIdx.x; asm volatile("" : "+v"(tid));
    for (int i = tid; i < 2 * nq; i += 512) {
        const int r = i / nq, ch = (i - r * nq) * 4;
        const size_t row = (size_t)pm * 256 + r;
        f32x4 val[2];
#pragma unroll
        for (int s = 0; s < (MODE == 0 ? 2 : 1); ++s) {
            const int co = (s ? voff : 0) + ch;
            f32x4 a = *(const f32x4*)(PART + (size_t)(pm * 2 + r) * C + co);
            if ((pm & 63) != 0) {
                const f32x4 t1 = *(const f32x4*)(TAIL + (size_t)((pm - 1) * 2 + 1) * C + co);
                const f32x4 w0 = *(const f32x4*)(cw + co);
                if (r == 0) { const f32x4 t2 = *(const f32x4*)(TAIL + (size_t)((pm - 1) * 2 + 0) * C + co); const f32x4 w1 = *(const f32x4*)(cw + C + co); a += w1 * t1 + w0 * t2; }
                else a += w0 * t1;
            }
            val[s] = a;
        }
        f32x4 o;
        if (MODE == 0) {
#pragma unroll
            for (int j = 0; j < 4; ++j) o[j] = pg8::silu_f(val[0][j]) * val[1][j];
        } else {
            const u32x2 bg = *(const u32x2*)(BG + row * D + ch);
            o[0] = __uint_as_float(bg.x << 16) * val[0][0]; o[1] = __uint_as_float(bg.x & 0xffff0000u) * val[0][1];
            o[2] = __uint_as_float(bg.y << 16) * val[0][2]; o[3] = __uint_as_float(bg.y & 0xffff0000u) * val[0][3];
        }
        u32x2 w; w.x = cvt_pk_bf16(o[0], o[1]); w.y = cvt_pk_bf16(o[2], o[3]);
        *(u32x2*)(O + img_off((int)row, ch, ldo)) = w;
    }
}
template <int MODE>
__device__ void fixup_mine(const pg8::StaticOrder& S, const float* cw, int C, int voff, int nch, const float* PART, const float* TAIL, bf16_t* O, int ldo, const bf16_t* BG) {
    pg8::Unit u; int last_pm = -1;
    for (int i = 0; S.next(i, u); ++i) { if (u.pm != last_pm) fixup_tile<MODE>(u.pm, cw, C, voff, nch, PART, TAIL, O, ldo, BG); last_pm = u.pm; }
    asm volatile("s_waitcnt vmcnt(0)" ::: "memory");
    __syncthreads();
}

#define XB_TMO      128
#define XB_XCNT(j)  (256  + 64 * (j))
#define XB_XSUB(j)  (1280 + 64 * (j))
#define XB_XGEN(j)  (2304 + 64 * (j))
#define XB_TOP      3328
#define XB_TOPGEN   3392
#define XCD_BAR_WORDS 3456
#define XB_SPIN_CAP (1u << 22)
__device__ __forceinline__ unsigned xb_ld(unsigned* p)              { return __hip_atomic_load(p, __ATOMIC_RELAXED, __HIP_MEMORY_SCOPE_AGENT); }
__device__ __forceinline__ unsigned xb_add(unsigned* p, unsigned v) { return __hip_atomic_fetch_add(p, v, __ATOMIC_RELAXED, __HIP_MEMORY_SCOPE_AGENT); }
__device__ __forceinline__ unsigned xb_xcc_id() { return (unsigned)__builtin_amdgcn_s_getreg((3 << 11) | 20) & 0xFu; }
#define XB_SPIN(cond, bar) do { unsigned _sp = 0; while (cond) { __builtin_amdgcn_s_sleep(1); \
    if ((++_sp & 255u) == 0u) { if (xb_ld(&(bar)[XB_TMO])) break; if (_sp > XB_SPIN_CAP) { atomicAdd(&(bar)[XB_TMO], 1u); break; } } } } while (0)
struct XcdBarrier { unsigned* bar; unsigned x; volatile LAS unsigned* st; };
__device__ __forceinline__ XcdBarrier xcd_barrier_post(unsigned* bar, volatile LAS unsigned* st) {
    XcdBarrier b; b.bar = bar; b.x = xb_xcc_id(); b.st = st;
    if (threadIdx.x == 0) (void)xb_add(&bar[XB_XCNT(b.x)], 1u);
    return b;
}
__device__ __forceinline__ void xcd_barrier_complete(unsigned* bar, unsigned x, unsigned& nloc, unsigned& nx) {
    const unsigned G = gridDim.x * gridDim.y * gridDim.z;
    unsigned sum, cnt, mine, sp = 0u;
    for (;;) {
        sum = 0u; cnt = 0u; mine = 0u;
#pragma unroll
        for (unsigned j = 0; j < 16; ++j) { const unsigned c = xb_ld(&bar[XB_XCNT(j)]); sum += c; cnt += (c > 0u) ? 1u : 0u; mine = (j == x) ? c : mine; }
        if (sum == G) break;
        __builtin_amdgcn_s_sleep(1);
        if ((++sp & 255u) == 0u) { if (xb_ld(&bar[XB_TMO])) break; if (sp > XB_SPIN_CAP) { atomicAdd(&bar[XB_TMO], 1u); break; } }
    }
    nloc = mine > 0u ? mine : 1u; nx = cnt > 0u ? cnt : 1u;
}
__device__ __forceinline__ void xcd_barrier(const XcdBarrier& b) {
    asm volatile("s_waitcnt vmcnt(0)" ::: "memory");
    __syncthreads();
    if (threadIdx.x == 0) {
        unsigned* bar = b.bar;
        __builtin_amdgcn_s_waitcnt(0);
        unsigned nloc = b.st[0], nx = b.st[1];
        if (nloc == 0u) { xcd_barrier_complete(bar, b.x, nloc, nx); b.st[0] = nloc; b.st[1] = nx; }
        const unsigned old = xb_add(&bar[XB_XSUB(b.x)], 1u);
        const unsigned gen = old / nloc;
        if (old + 1u == (gen + 1u) * nloc) {
            __builtin_amdgcn_fence(__ATOMIC_RELEASE, "agent");
            asm volatile("s_waitcnt vmcnt(0)" ::: "memory");
            const unsigned og = xb_add(&bar[XB_TOP], 1u);
            const unsigned tg = og / nx;
            if (og + 1u == (tg + 1u) * nx) xb_add(&bar[XB_TOPGEN], 1u);
            else XB_SPIN(xb_ld(&bar[XB_TOPGEN]) == tg, bar);
            __builtin_amdgcn_fence(__ATOMIC_ACQUIRE, "agent");
            xb_add(&bar[XB_XGEN(b.x)], 1u);
            asm volatile("s_waitcnt vmcnt(0)" ::: "memory");
        } else {
            XB_SPIN(xb_ld(&bar[XB_XGEN(b.x)]) == gen, bar);
            __builtin_amdgcn_fence(__ATOMIC_ACQUIRE, "agent");
            asm volatile("s_waitcnt vmcnt(0)" ::: "memory");
        }
    }
    __syncthreads();
}

constexpr int XB_LDS_OFF = pg8::STAGE_BYTES + 8192 + 4096;
constexpr int LDS_BYTES = XB_LDS_OFF + 16;

__device__ __forceinline__ const Params* kparams() { int z = 0; asm volatile("" : "+s"(z)); z = __builtin_amdgcn_readfirstlane(z);
    return (const Params*)((const char*)__builtin_amdgcn_kernarg_segment_ptr() + z); }

__device__ __forceinline__ int opaque_count(int n) { asm volatile("" : "+s"(n)); return __builtin_amdgcn_readfirstlane(n); }

__global__ void __launch_bounds__(512, 2) fwd_megakernel(Params p_unused) {
    extern __shared__ __attribute__((aligned(16))) unsigned char lds_raw[];
    LAS unsigned char* lds = (LAS unsigned char*)lds_raw;
    cg::grid_group grid = cg::this_grid();
    { LAS unsigned* xbst = (LAS unsigned*)(lds + XB_LDS_OFF); if (threadIdx.x == 0) { xbst[0] = 0u; xbst[1] = 0u; } }
    __syncthreads();
    (void)xcd_barrier_post((unsigned*)(kparams()->ws + WS_BAR), (volatile LAS unsigned*)(lds + XB_LDS_OFF));
#define SEAM() do { XcdBarrier xb_; xb_.bar = (unsigned*)(kparams()->ws + WS_BAR); xb_.x = xb_xcc_id(); xb_.st = (volatile LAS unsigned*)(lds + XB_LDS_OFF); xcd_barrier(xb_); } while (0)
#define WSP(T, off) ((T*)(q->ws + (off)))
    constexpr int NOGRP = 30;
    const int G = gridDim.x;

#ifndef PROBE_PHASE
#define PROBE_PHASE -1
#endif
#define REPEAT(k) for (int rep_ = 0, n_ = opaque_count((k) == PROBE_PHASE ? 2 : 1); rep_ < n_; ++rep_)
#define XOUT() ((n_ == 2 && rep_ == 0) ? WSP(bf16_t, WS_END) : WSP(bf16_t, WS_X))
    if (threadIdx.x == 0) { unsigned* bw = (unsigned*)(kparams()->ws + WS_BAR); const unsigned xcc = xb_xcc_id(); const unsigned rank = xb_add(&bw[4 * xcc], 1u);
        ((LAS unsigned*)(lds + XB_LDS_OFF))[2] = rank * 8u + xcc; }
    if (opaque_count(0)) grid.sync();
    REPEAT(0) { phase0(*kparams(), lds); SEAM(); }
    int bid = blockIdx.x;
    { unsigned* bw = (unsigned*)(kparams()->ws + WS_BAR); bool ok = (gridDim.x == 256);
#pragma unroll
      for (int j = 0; j < 16; ++j) ok = ok && (xb_ld(&bw[4 * j]) == (j < 8 ? 32u : 0u));
      const int vc = (int)((LAS unsigned*)(lds + XB_LDS_OFF))[2];
      bid = __builtin_amdgcn_readfirstlane(ok ? vc : bid); }
    REPEAT(1) { phase1(*kparams(), lds); SEAM(); }
    REPEAT(2) {
        const Params* q = kparams();
        pg8::Gemm g{WSP(bf16_t, WS_H), WSP(bf16_t, WS_WPOOL), M, D, 512, D, 1, 8 * 16384}; pg8::StaticOrder S; S.init(M, D, G, bid);
        pg8::EpiRes<true> E{q->x, WSP(bf16_t, WS_X), WSP(float, WS_MOD) + 2 * D, q->pool_scale};
        pg8::gemm_phase(lds, g, S, E);
        SEAM();
    }
#pragma unroll
    for (int l = 0; l < 2; ++l) {
        if (l == 1) {
            REPEAT(7) { const Params* q = kparams(); const float* modl = WSP(float, WS_MOD) + (size_t)l * 2 * MODW;
              norm_phase<false>(WSP(bf16_t, WS_X), WSP(bf16_t, WS_H), q->n1g + D, modl + 0 * D, modl + 1 * D); SEAM(); }
            REPEAT(8) {
                const Params* q = kparams();
                pg8::Gemm g{WSP(bf16_t, WS_H), WSP(bf16_t, WS_WBCX), M, D, D, D, NOGRP, 0}; pg8::StaticOrder S; S.init(M, D, G, bid);
                pg8::EpiBf16 E{WSP(bf16_t, WS_ACT), D};
                pg8::gemm_phase(lds, g, S, E);
                SEAM();
            }
            REPEAT(9) {
                const Params* q = kparams();
                pg8::Gemm g{WSP(bf16_t, WS_H), WSP(bf16_t, WS_WBCX) + (size_t)D * D, M, 2 * D, D, D, NOGRP, 0}; pg8::StaticOrder S; S.init(M, 2 * D, G, bid);
                pg8::EpiConv<1> E{q->sconv_w, q->sconv_b, D, 0, WSP(bf16_t, WS_ACT) + (size_t)M * D, D, WSP(bf16_t, WS_ACT), WSP(float, WS_PART), WSP(float, WS_TAIL)};
                pg8::gemm_phase(lds, g, S, E);
                SEAM();
            }
            REPEAT(11) {
                const Params* q = kparams();
                pg8::Gemm g{WSP(bf16_t, WS_ACT) + (size_t)M * D, WSP(bf16_t, WS_WSOUT), M, D, D, D, NOGRP, 0}; pg8::StaticOrder S; S.init(M, D, G, bid);
                fixup_mine<1>(S, q->sconv_w, D, 0, D, WSP(float, WS_PART), WSP(float, WS_TAIL), WSP(bf16_t, WS_ACT) + (size_t)M * D, D, WSP(bf16_t, WS_ACT));
                pg8::EpiRes<false> E{WSP(bf16_t, WS_X), XOUT(), WSP(float, WS_MOD) + (size_t)l * 2 * MODW + 2 * D, nullptr};
                pg8::gemm_phase(lds, g, S, E);
                SEAM();
            }
        }
        REPEAT(l == 0 ? 3 : 12) { const Params* q = kparams(); const float* modl = WSP(float, WS_MOD) + (size_t)l * 2 * MODW;
          norm_phase<false>(WSP(bf16_t, WS_X), WSP(bf16_t, WS_H), q->n2g + l * D, modl + 3 * D, modl + 4 * D); SEAM(); }
        REPEAT(l == 0 ? 4 : 13) {
            const Params* q = kparams();
            pg8::Gemm g{WSP(bf16_t, WS_H), WSP(bf16_t, WS_WUP) + (size_t)l * NUP * D, M, NUP, D, D, NOGRP, 0}; pg8::StaticOrder S; S.init(M, NUP, G, bid);
            pg8::EpiConv<0> E{q->fconv_w + (size_t)l * 3 * NUP, q->fconv_b + (size_t)l * NUP, NUP, FF, WSP(bf16_t, WS_ACT), FF, nullptr, WSP(float, WS_PART), WSP(float, WS_TAIL)};
            pg8::gemm_phase(lds, g, S, E);
            SEAM();
        }
        REPEAT(l == 0 ? 6 : 15) {
            const Params* q = kparams();
            pg8::Gemm g{WSP(bf16_t, WS_ACT), WSP(bf16_t, WS_WDOWN) + (size_t)l * D * FF, M, D, FF, FF, NOGRP, 0}; pg8::StaticOrder S; S.init(M, D, G, bid);
            fixup_mine<0>(S, q->fconv_w + (size_t)l * 3 * NUP, NUP, FF, FF, WSP(float, WS_PART), WSP(float, WS_TAIL), WSP(bf16_t, WS_ACT), FF, nullptr);
            pg8::EpiRes<false> E{WSP(bf16_t, WS_X), XOUT(), WSP(float, WS_MOD) + (size_t)l * 2 * MODW + 5 * D, nullptr};
            pg8::gemm_phase(lds, g, S, E);
            SEAM();
        }
    }
    REPEAT(16) { const Params* q = kparams(); norm_phase<true>(WSP(bf16_t, WS_X), q->out, q->final_g, nullptr, nullptr); if (n_ == 2 && rep_ == 0) SEAM(); }
#undef REPEAT
#undef XOUT
#undef SEAM
#undef WSP
}

extern "C" void kernel_launch(void* const* d_in, const int* in_sizes, int n_in, void* d_out, int out_size, void* d_ws, size_t ws_size, hipStream_t stream) {
    static int grid_blocks = 0;
    if (grid_blocks == 0) {
        if (n_in != 17 || out_size != M * D || ws_size < WS_END) { fprintf(stderr, "kernel_launch: unexpected shapes (n_in %d out %d ws %zu need %zu)\n", n_in, out_size, ws_size, (size_t)WS_END); grid_blocks = -1; return; }
        int dev = 0, cus = 0, per_cu = 0;
        hipGetDevice(&dev);
        hipDeviceGetAttribute(&cus, hipDeviceAttributeMultiprocessorCount, dev);
        if (hipFuncSetAttribute((const void*)fwd_megakernel, hipFuncAttributeMaxDynamicSharedMemorySize, LDS_BYTES) != hipSuccess) { fprintf(stderr, "kernel_launch: hipFuncSetAttribute failed\n"); grid_blocks = -1; return; }
        if (hipOccupancyMaxActiveBlocksPerMultiprocessor(&per_cu, (const void*)fwd_megakernel, 512, LDS_BYTES) != hipSuccess || per_cu < 1) { fprintf(stderr, "kernel_launch: occupancy query says %d\n", per_cu); per_cu = 1; }
        (void)hipGetLastError();
        grid_blocks = cus;
    }
    if (grid_blocks < 0) return;
    if (hipMemsetAsync((char*)d_ws + WS_BAR, 0, 16384, stream) != hipSuccess) { fprintf(stderr, "kernel_launch: hipMemsetAsync failed\n"); return; }
    Params p{};
    const float** pp = (const float**)&p;
    for (int i = 0; i < 17; ++i) pp[i] = (const float*)d_in[i];
    p.out = (float*)d_out; p.ws = (unsigned char*)d_ws; p.ph_lo = 0; p.ph_hi = 0;
    void* args[] = {&p};
    hipError_t e = hipLaunchCooperativeKernel((const void*)fwd_megakernel, dim3(grid_blocks), dim3(512), args, LDS_BYTES, stream);
    if (e != hipSuccess) fprintf(stderr, "cooperative launch failed: %s (grid %d)\n", hipGetErrorString(e), grid_blocks);
}
```
